# Optimizing an MI355X kernel written in HIP

```python
import math
import jax
import jax.numpy as jnp
from jax import lax
import numpy as np

D_MODEL = 1024
BATCH = 2
SEQ = 8192
DEPTH = 2

HEAD_DIM = 64
A_HEADS = 16
A_WIDTH = A_HEADS * HEAD_DIM
DILATED_PAIRS = ((128, 1), (512, 4), (2048, 16))
B_HEADS = D_MODEL // (2 * HEAD_DIM)
B_QK_WIDTH = 2 * B_HEADS * HEAD_DIM
B_V_DIM = 2 * HEAD_DIM
B_WIDTH = B_HEADS * B_V_DIM
IN_WIDTHS = (A_WIDTH, A_WIDTH, A_WIDTH, A_WIDTH,
             B_QK_WIDTH, B_QK_WIDTH, B_WIDTH, B_WIDTH,
             D_MODEL, D_MODEL)
IN_TOTAL = sum(IN_WIDTHS)
ROPE_THETA = 500000.0
ROPE_DIM = HEAD_DIM // 4
Q_BLOCK = 128
RMS_EPS = 1e-6
SUBLN_EPS = 1e-5
NEG = -1e30

kernel_name = 'hybrid_dilated_diff_gated_trunk'


def rms_norm(x, w, eps):
    xf = x.astype(jnp.float32)
    return xf * lax.rsqrt(jnp.mean(xf * xf, axis=-1, keepdims=True) + eps) * w.astype(jnp.float32)


def rope_tables(seq):
    inv = 1.0 / (ROPE_THETA ** (jnp.arange(0, ROPE_DIM, 2, dtype=jnp.float32) / ROPE_DIM))
    ang = jnp.arange(seq, dtype=jnp.float32)[:, None] * inv[None, :]
    return jnp.cos(ang), jnp.sin(ang)


def partial_rope(t, cos, sin):
    half = ROPE_DIM // 2
    tr = t[..., :ROPE_DIM].astype(jnp.float32)
    t1, t2 = tr[..., :half], tr[..., half:]
    c = cos[None, :, None, :]
    s = sin[None, :, None, :]
    rot = jnp.concatenate([t1 * c - t2 * s, t1 * s + t2 * c], axis=-1).astype(t.dtype)
    return jnp.concatenate([rot, t[..., ROPE_DIM:]], axis=-1)


def split_cols(u):
    outs = []
    start = 0
    for w in IN_WIDTHS:
        outs.append(u[..., start:start + w])
        start += w
    return outs


def dilated_pattern(q, k, v, window, dilation):
    b, s, h, dh = q.shape
    n = window // dilation
    chunk = dilation * n
    sp = -(-s // chunk) * chunk
    length = sp // dilation
    nb = length // n

    def to_blocks(t):
        t = jnp.pad(t, ((0, 0), (0, sp - s), (0, 0), (0, 0)))
        t = t.reshape(b, length, dilation, h, dh).transpose(0, 2, 1, 3, 4)
        return t.reshape(b, dilation, nb, n, h, dh)

    def with_prev(t):
        prev = jnp.pad(t, ((0, 0), (0, 0), (1, 0), (0, 0), (0, 0), (0, 0)))[:, :, :-1]
        return jnp.concatenate([prev, t], axis=3)

    qb = to_blocks(q)
    kb = with_prev(to_blocks(k))
    vb = with_prev(to_blocks(v))
    scores = jnp.einsum('brnqhd,brnkhd->brnqhk', qb, kb,
                        preferred_element_type=jnp.float32) * (HEAD_DIM ** -0.5)
    qi = jnp.arange(n)[:, None]
    kc = jnp.arange(2 * n)[None, :]
    dist = qi + n - kc
    blk = jnp.arange(nb)[:, None, None]
    valid = (dist >= 0) & (dist <= n) & (blk * n + kc - n >= 0)
    scores = jnp.where(valid[None, None, :, :, None, :], scores, NEG)
    m = jnp.max(scores, axis=-1)
    p = jnp.exp(scores - m[..., None])
    den = jnp.sum(p, axis=-1)
    o = jnp.einsum('brnqhk,brnkhd->brnqhd', p, vb.astype(jnp.float32)) / den[..., None]

    def from_blocks(t):
        t = t.reshape((b, dilation, length) + t.shape[4:])
        t = jnp.swapaxes(t, 1, 2)
        return t.reshape((b, sp) + t.shape[3:])[:, :s]

    return from_blocks(o), from_blocks(m), from_blocks(den)


def dilated_mixture(q, k, v):
    outs = [dilated_pattern(q, k, v, w, d) for (w, d) in DILATED_PAIRS]
    m_all = jnp.stack([r[1] for r in outs])
    d_all = jnp.stack([r[2] for r in outs])
    o_all = jnp.stack([r[0] for r in outs])
    wts = d_all * jnp.exp(m_all - jnp.max(m_all, axis=0))
    return jnp.sum(wts[..., None] * o_all, axis=0) / jnp.sum(wts, axis=0)[..., None]


def diff_attention(q1, q2, k1, k2, v, lam):
    b, s, h, dh = q1.shape
    nq = s // Q_BLOCK
    qs = jnp.stack([q1, q2], 0).reshape(2, b, nq, Q_BLOCK, h, dh).transpose(2, 0, 1, 3, 4, 5)
    ks = jnp.stack([k1, k2], 0)
    vf = v.astype(jnp.float32)
    kpos = jnp.arange(s)

    def one_block(args):
        qblk, bi = args
        sc = jnp.einsum('mbqhd,mbkhd->mbhqk', qblk, ks,
                        preferred_element_type=jnp.float32) * (dh ** -0.5)
        qpos = bi * Q_BLOCK + jnp.arange(Q_BLOCK)
        sc = jnp.where(kpos[None, :] <= qpos[:, None], sc, NEG)
        p = jax.nn.softmax(sc, axis=-1)
        a = p[0] - lam * p[1]
        return jnp.einsum('bhqk,bkhe->bqhe', a, vf)

    out = lax.map(one_block, (qs, jnp.arange(nq)))
    return out.transpose(1, 0, 2, 3, 4).reshape(b, s, h, 2 * dh)


def lambda_init_value(layer):
    return 0.8 - 0.6 * math.exp(-0.3 * layer)


def hybrid_layer(x, layer, norm_w, w_in, lq1, lk1, lq2, lk2, subln_w,
                 w_proj_a, w_proj_b, w_out, cos, sin):
    b, s, _ = x.shape
    hdn = rms_norm(x, norm_w, RMS_EPS).astype(x.dtype)
    u = hdn @ w_in
    qa, ka, va, za, qb, kb, vb, zb, ga, gb = split_cols(u)

    qa = partial_rope(qa.reshape(b, s, A_HEADS, HEAD_DIM), cos, sin)
    ka = partial_rope(ka.reshape(b, s, A_HEADS, HEAD_DIM), cos, sin)
    va = va.reshape(b, s, A_HEADS, HEAD_DIM)
    ya = dilated_mixture(qa, ka, va).reshape(b, s, A_WIDTH)
    ya = ya * jax.nn.silu(za.astype(jnp.float32))

    qb = partial_rope(qb.reshape(b, s, 2 * B_HEADS, HEAD_DIM), cos, sin)
    kb = partial_rope(kb.reshape(b, s, 2 * B_HEADS, HEAD_DIM), cos, sin)
    vb = vb.reshape(b, s, B_HEADS, B_V_DIM)
    lam_init = lambda_init_value(layer)
    lam = (jnp.exp(jnp.sum(lq1.astype(jnp.float32) * lk1.astype(jnp.float32)))
           - jnp.exp(jnp.sum(lq2.astype(jnp.float32) * lk2.astype(jnp.float32))) + lam_init)
    ob = diff_attention(qb[:, :, 0::2], qb[:, :, 1::2], kb[:, :, 0::2], kb[:, :, 1::2], vb, lam)
    ob = rms_norm(ob, subln_w, SUBLN_EPS) * (1.0 - lam_init)
    yb = ob.reshape(b, s, B_WIDTH) * jax.nn.silu(zb.astype(jnp.float32))

    pa = ya.astype(x.dtype) @ w_proj_a
    pb = yb.astype(x.dtype) @ w_proj_b
    merged = (jax.nn.sigmoid(ga.astype(jnp.float32)) * pa.astype(jnp.float32)
              + jax.nn.sigmoid(gb.astype(jnp.float32)) * pb.astype(jnp.float32))
    return x + (merged.astype(x.dtype) @ w_out).astype(x.dtype)


def setup_inputs(seed: int = 0) -> dict:
    key = jax.random.key(seed)
    ks = jax.random.split(key, 16)
    f32 = jnp.float32
    x = jax.random.normal(ks[0], (BATCH, SEQ, D_MODEL), f32)
    norm_w = 1.0 + 0.02 * jax.random.normal(ks[1], (DEPTH, D_MODEL), f32)
    w_in = jax.random.normal(ks[2], (DEPTH, D_MODEL, IN_TOTAL), f32) * D_MODEL ** -0.5
    lambda_q1 = 0.1 * jax.random.normal(ks[3], (DEPTH, HEAD_DIM), f32)
    lambda_k1 = 0.1 * jax.random.normal(ks[4], (DEPTH, HEAD_DIM), f32)
    lambda_q2 = 0.1 * jax.random.normal(ks[5], (DEPTH, HEAD_DIM), f32)
    lambda_k2 = 0.1 * jax.random.normal(ks[6], (DEPTH, HEAD_DIM), f32)
    subln_w = 1.0 + 0.02 * jax.random.normal(ks[7], (DEPTH, B_V_DIM), f32)
    w_proj_a = jax.random.normal(ks[8], (DEPTH, A_WIDTH, D_MODEL), f32) * A_WIDTH ** -0.5
    w_proj_b = jax.random.normal(ks[9], (DEPTH, B_WIDTH, D_MODEL), f32) * B_WIDTH ** -0.5
    w_out = jax.random.normal(ks[10], (DEPTH, D_MODEL, D_MODEL), f32) * D_MODEL ** -0.5
    final_norm_w = 1.0 + 0.02 * jax.random.normal(ks[11], (D_MODEL,), f32)
    return {'x': x, 'norm_w': norm_w, 'w_in': w_in,
            'lambda_q1': lambda_q1, 'lambda_k1': lambda_k1,
            'lambda_q2': lambda_q2, 'lambda_k2': lambda_k2,
            'subln_w': subln_w, 'w_proj_a': w_proj_a, 'w_proj_b': w_proj_b,
            'w_out': w_out, 'final_norm_w': final_norm_w}


def reference(x, norm_w, w_in, lambda_q1, lambda_k1, lambda_q2, lambda_k2,
              subln_w, w_proj_a, w_proj_b, w_out, final_norm_w):
    cos, sin = rope_tables(x.shape[1])
    h = x
    for layer in range(DEPTH):
        h = hybrid_layer(h, layer, norm_w[layer], w_in[layer],
                         lambda_q1[layer], lambda_k1[layer], lambda_q2[layer], lambda_k2[layer],
                         subln_w[layer], w_proj_a[layer], w_proj_b[layer], w_out[layer],
                         cos, sin)
    return rms_norm(h, final_norm_w, RMS_EPS).astype(x.dtype)
```

```cpp
#include <hip/hip_runtime.h>
#include <hip/hip_cooperative_groups.h>
#include <cstdio>
#include <cstdint>
namespace cg = cooperative_groups;
namespace pg8 {
#define PG8_LAS __attribute__((address_space(3)))
typedef unsigned short bf16_t;
typedef short bf16x8 __attribute__((ext_vector_type(8)));
typedef float f32x4 __attribute__((ext_vector_type(4)));
typedef unsigned u32x4 __attribute__((ext_vector_type(4)));
constexpr int BM = 256, BK = 64, HALF = 128, HTB = HALF * BK * 2  , STAGE_BYTES = 8 * HTB, NXCD = 8, WGM = 8;

__host__ __device__ __forceinline__ int lds_byte(int r, int c) { const int st = (r >> 4) * 2 + (c >> 5), rr = r & 15, cc = c & 31, ob = rr * 64 + cc * 2; return st * 1024 + (ob ^ (((ob >> 9) & 1) << 5)); }
__host__ __device__ __forceinline__ void stage_rc(int b, int& R, int& C) { const int st = b / 1024, sb = b % 1024, swz = sb ^ (((sb >> 9) & 1) << 5); R = (st >> 1) * 16 + swz / 64; C = (st & 1) * 32 + (swz % 64) / 2; }
__host__ __device__ __forceinline__ int perm32(int rho) { const int n = rho >> 4, i = rho & 15; return 8 * (i >> 2) + 4 * n + (i & 3); }

struct Unit { int pm, pn; };
struct Gemm { const bf16_t* A; const bf16_t* Bt; int M, N, K; };

struct StaticOrder {
    int nM, nN, nwg, G, c;
    __host__ __device__ void init(int M, int N, int G_, int c_) { nM = M / BM; nN = N / BM; nwg = nM * nN; G = G_; c = c_; }
    __host__ __device__ bool next(int i, Unit& u) const {
        const long L = (long)i * G + c; if (L >= nwg) return false;
        int wgid = (int)L; { const int q = nwg / NXCD, r = nwg % NXCD, xcd = wgid % NXCD, off = wgid / NXCD; wgid = (xcd < r ? xcd * (q + 1) : r * (q + 1) + (xcd - r) * q) + off; }
        const int nig = WGM * nN, gid = wgid / nig, fm = gid * WGM, gsz = (nM - fm) < WGM ? (nM - fm) : WGM;
        u.pm = fm + ((wgid % nig) % gsz); u.pn = (wgid % nig) / gsz; return true;
    }
    __device__ __forceinline__ void a_ready(const Unit&) const {}
    __device__ __forceinline__ void done(const Unit&) const {}
};

__device__ __forceinline__ unsigned cvt_pk_bf16(float lo, float hi) { unsigned r; asm volatile("v_cvt_pk_bf16_f32 %0, %1, %2" : "=v"(r) : "v"(lo), "v"(hi)); return r; }
typedef float f32x2 __attribute__((ext_vector_type(2)));
typedef unsigned u32x2 __attribute__((ext_vector_type(2)));
__device__ __forceinline__ float bf_lo(unsigned w) { return __uint_as_float(w << 16); }
__device__ __forceinline__ float bf_hi(unsigned w) { return __uint_as_float(w & 0xffff0000u); }
__device__ __forceinline__ float sigmoid_f(float x) { return __builtin_amdgcn_rcpf(1.0f + __builtin_amdgcn_exp2f(-1.4426950408889634f * x)); }
__device__ __forceinline__ void unpack8(const u32x4 w, float (&f)[8]) { f[0] = bf_lo(w.x); f[1] = bf_hi(w.x); f[2] = bf_lo(w.y); f[3] = bf_hi(w.y); f[4] = bf_lo(w.z); f[5] = bf_hi(w.z); f[6] = bf_lo(w.w); f[7] = bf_hi(w.w); }
__device__ __forceinline__ u32x4 pack8(const float (&f)[8]) { u32x4 w; w.x = cvt_pk_bf16(f[0], f[1]); w.y = cvt_pk_bf16(f[2], f[3]); w.z = cvt_pk_bf16(f[4], f[5]); w.w = cvt_pk_bf16(f[6], f[7]); return w; }

struct EpiQKV {
    static constexpr bool PERM = true, AFTER_DRAIN = false;
    bf16_t* O; size_t gstride; const float* cs; float qscale;
    __device__ __forceinline__ void operator()(const f32x4 (&acc)[2][2][4][2], const Unit& u, int wr, int wc, int fr, int fq) const {
        const int t = u.pn >> 2, colt = (u.pn & 3) * BM;
        bf16_t* base = O + (size_t)t * gstride;
        const bool is_rope = (t != 2) && (t != 5);
        const float sc = (t == 0 || t == 3) ? qscale : 1.f;
        const int row0 = u.pm * BM + wr * 64 + fr, col0 = colt + wc * 32 + 8 * fq;
        const bool ropew = is_rope && ((wc & 1) == 0);
        const bool ropel = fq < 2;
        const float sgn = (fq == 0) ? -1.f : 1.f;
#pragma unroll
        for (int ai = 0; ai < 2; ++ai)
#pragma unroll
            for (int m = 0; m < 4; ++m) {
                const int row = row0 + ai * HALF + m * 16;
                bf16_t* rowp = base + (size_t)row * 1024 + col0;
                f32x4 c01 = {1.f, 0.f, 1.f, 0.f}, c23 = c01, c45 = c01, c67 = c01;
                if (ropew) { const f32x4* cp = (const f32x4*)(cs + (size_t)(row & 8191) * 16); c01 = cp[0]; c23 = cp[1]; c45 = cp[2]; c67 = cp[3]; }
#pragma unroll
                for (int bj = 0; bj < 2; ++bj) {
                    float v[8]; { const f32x4 v0 = acc[ai][bj][m][0], v1 = acc[ai][bj][m][1]; v[0] = v0[0]; v[1] = v0[1]; v[2] = v0[2]; v[3] = v0[3]; v[4] = v1[0]; v[5] = v1[1]; v[6] = v1[2]; v[7] = v1[3]; }
                    if (ropew) {
                        float p[8];
#pragma unroll
                        for (int j = 0; j < 8; ++j) p[j] = __shfl_xor(v[j], 16);
                        if (ropel) {
                            v[0] = v[0] * c01[0] + sgn * p[0] * c01[1]; v[1] = v[1] * c01[2] + sgn * p[1] * c01[3];
                            v[2] = v[2] * c23[0] + sgn * p[2] * c23[1]; v[3] = v[3] * c23[2] + sgn * p[3] * c23[3];
                            v[4] = v[4] * c45[0] + sgn * p[4] * c45[1]; v[5] = v[5] * c45[2] + sgn * p[5] * c45[3];
                            v[6] = v[6] * c67[0] + sgn * p[6] * c67[1]; v[7] = v[7] * c67[2] + sgn * p[7] * c67[3];
                        }
                    }
#pragma unroll
                    for (int j = 0; j < 8; ++j) v[j] *= sc;
                    *(u32x4*)(rowp + bj * HALF) = pack8(v);
                }
            }
    }
};
struct EpiZG {
    static constexpr bool PERM = true, AFTER_DRAIN = false;
    bf16_t* O; size_t gstride; const bf16_t* mul0; const bf16_t* mul1;
    __device__ __forceinline__ void operator()(const f32x4 (&acc)[2][2][4][2], const Unit& u, int wr, int wc, int fr, int fq) const {
        const int t = u.pn >> 2, colt = (u.pn & 3) * BM;
        bf16_t* base = O + (size_t)t * gstride;
        const bf16_t* mul = (t == 0) ? mul0 : mul1;
        const int row0 = u.pm * BM + wr * 64 + fr, col0 = colt + wc * 32 + 8 * fq;
#pragma unroll
        for (int ai = 0; ai < 2; ++ai)
#pragma unroll
            for (int m = 0; m < 4; ++m) {
                const size_t off = (size_t)(row0 + ai * HALF + m * 16) * 1024 + col0;
#pragma unroll
                for (int bj = 0; bj < 2; ++bj) {
                    float v[8]; { const f32x4 v0 = acc[ai][bj][m][0], v1 = acc[ai][bj][m][1]; v[0] = v0[0]; v[1] = v0[1]; v[2] = v0[2]; v[3] = v0[3]; v[4] = v1[0]; v[5] = v1[1]; v[6] = v1[2]; v[7] = v1[3]; }
                    if (t < 2) {
                        float mv[8]; unpack8(*(const u32x4*)(mul + off + bj * HALF), mv);
#pragma unroll
                        for (int j = 0; j < 8; ++j) v[j] = v[j] * sigmoid_f(v[j]) * mv[j];
                    } else {
#pragma unroll
                        for (int j = 0; j < 8; ++j) v[j] = sigmoid_f(v[j]);
                    }
                    *(u32x4*)(base + off + bj * HALF) = pack8(v);
                }
            }
    }
};
struct EpiGateF32 {
    static constexpr bool PERM = true, AFTER_DRAIN = false;
    float* T; const bf16_t* gate;
    __device__ __forceinline__ void operator()(const f32x4 (&acc)[2][2][4][2], const Unit& u, int wr, int wc, int fr, int fq) const {
        const int row0 = u.pm * BM + wr * 64 + fr, col0 = u.pn * BM + wc * 32 + 8 * fq;
#pragma unroll
        for (int ai = 0; ai < 2; ++ai)
#pragma unroll
            for (int m = 0; m < 4; ++m) {
                const size_t off = (size_t)(row0 + ai * HALF + m * 16) * 1024 + col0;
#pragma unroll
                for (int bj = 0; bj < 2; ++bj) {
                    float g[8]; unpack8(*(const u32x4*)(gate + off + bj * HALF), g);
                    const f32x4 v0 = acc[ai][bj][m][0], v1 = acc[ai][bj][m][1];
                    *(f32x4*)(T + off + bj * HALF) = (f32x4){v0[0] * g[0], v0[1] * g[1], v0[2] * g[2], v0[3] * g[3]};
                    *(f32x4*)(T + off + bj * HALF + 4) = (f32x4){v1[0] * g[4], v1[1] * g[5], v1[2] * g[6], v1[3] * g[7]};
                }
            }
    }
};
struct EpiMerge {
    static constexpr bool PERM = true, AFTER_DRAIN = false;
    const float* T; const bf16_t* gate; bf16_t* O;
    __device__ __forceinline__ void operator()(const f32x4 (&acc)[2][2][4][2], const Unit& u, int wr, int wc, int fr, int fq) const {
        const int row0 = u.pm * BM + wr * 64 + fr, col0 = u.pn * BM + wc * 32 + 8 * fq;
#pragma unroll
        for (int ai = 0; ai < 2; ++ai)
#pragma unroll
            for (int m = 0; m < 4; ++m) {
                const size_t off = (size_t)(row0 + ai * HALF + m * 16) * 1024 + col0;
#pragma unroll
                for (int bj = 0; bj < 2; ++bj) {
                    float g[8]; unpack8(*(const u32x4*)(gate + off + bj * HALF), g);
                    const f32x4 t0 = *(const f32x4*)(T + off + bj * HALF), t1 = *(const f32x4*)(T + off + bj * HALF + 4);
                    const f32x4 v0 = acc[ai][bj][m][0], v1 = acc[ai][bj][m][1];
                    float v[8] = {t0[0] + v0[0] * g[0], t0[1] + v0[1] * g[1], t0[2] + v0[2] * g[2], t0[3] + v0[3] * g[3], t1[0] + v1[0] * g[4], t1[1] + v1[1] * g[5], t1[2] + v1[2] * g[6], t1[3] + v1[3] * g[7]};
                    *(u32x4*)(O + off + bj * HALF) = pack8(v);
                }
            }
    }
};
struct EpiResid {
    static constexpr bool PERM = true, AFTER_DRAIN = false;
    const float* res; float* out;
    __device__ __forceinline__ void operator()(const f32x4 (&acc)[2][2][4][2], const Unit& u, int wr, int wc, int fr, int fq) const {
        const int row0 = u.pm * BM + wr * 64 + fr, col0 = u.pn * BM + wc * 32 + 8 * fq;
#pragma unroll
        for (int ai = 0; ai < 2; ++ai)
#pragma unroll
            for (int m = 0; m < 4; ++m) {
                const size_t off = (size_t)(row0 + ai * HALF + m * 16) * 1024 + col0;
#pragma unroll
                for (int bj = 0; bj < 2; ++bj) {
                    const f32x4 r0 = *(const f32x4*)(res + off + bj * HALF), r1 = *(const f32x4*)(res + off + bj * HALF + 4);
                    *(f32x4*)(out + off + bj * HALF) = r0 + acc[ai][bj][m][0];
                    *(f32x4*)(out + off + bj * HALF + 4) = r1 + acc[ai][bj][m][1];
                }
            }
    }
};

template <class Epi, class Sched, bool ALIGN_EPI = false, bool SP2 = false>
__device__ __forceinline__ void gemm_phase(PG8_LAS unsigned char* lds, const Gemm g, const Sched& S, const Epi& E) {
    const int tid = threadIdx.x, wid = __builtin_amdgcn_readfirstlane(tid >> 6), lane = tid & 63, wr = wid >> 2, wc = wid & 3, fr = lane & 15, fq = lane >> 4;
    const int K = g.K, nt = K / BK;
    unsigned voffA[2], voffB[2];
#pragma unroll
    for (int i = 0; i < 2; ++i) { int R, C; stage_rc(tid * 16 + i * 8192, R, C); const int Rb = Epi::PERM ? ((R & ~31) + perm32(R & 31)) : R;
        voffA[i] = (unsigned)(R * K + C) * 2u; voffB[i] = (unsigned)(Rb * K + C) * 2u; }
    const size_t kstep = (size_t)(BK * 2);
    const size_t hstep = (size_t)HALF * K * 2;
    const size_t tstep = 2 * hstep;
    const unsigned ldsw = (unsigned)wid * 1024u;
    const int aoff = lds_byte(wr * 64 + fr, fq * 8), boff = lds_byte(wc * 32 + fr, fq * 8);
#define PG8_SA(b, h) (((b) * 2 + (h)) * HTB)
#define PG8_SB(b, h) ((4 + (b) * 2 + (h)) * HTB)
#define PG8_STAGE(bufoff, gbase, voff) do { _Pragma("unroll") for (int _i = 0; _i < 2; ++_i) \
        __builtin_amdgcn_global_load_lds((const unsigned*)((const char*)(gbase) + (voff)[_i]), (PG8_LAS unsigned*)(lds + (bufoff) + ldsw + _i * 8192), 16, 0, 0); } while (0)
#define PG8_LDA(dst, b, h) do { _Pragma("unroll") for (int m = 0; m < 4; ++m) _Pragma("unroll") for (int k = 0; k < 2; ++k) dst[m][k] = *(const PG8_LAS bf16x8*)(lds + PG8_SA(b, h) + aoff + m * 2048 + k * 1024); } while (0)
#define PG8_LDB(dst, b, h) do { _Pragma("unroll") for (int n = 0; n < 2; ++n) _Pragma("unroll") for (int k = 0; k < 2; ++k) dst[n][k] = *(const PG8_LAS bf16x8*)(lds + PG8_SB(b, h) + boff + n * 2048 + k * 1024); } while (0)
#define PG8_MMA(ai, bj, At, Bt) do { __builtin_amdgcn_s_setprio(1); _Pragma("unroll") for (int m = 0; m < 4; ++m) _Pragma("unroll") for (int n = 0; n < 2; ++n) _Pragma("unroll") for (int k = 0; k < 2; ++k) \
        acc[ai][bj][m][n] = __builtin_amdgcn_mfma_f32_16x16x32_bf16(Bt[n][k], At[m][k], acc[ai][bj][m][n], 0, 0, 0); __builtin_amdgcn_s_setprio(0); } while (0)
#define PG8_WAIT_V(n) asm volatile("s_waitcnt vmcnt(" #n ")" ::: "memory")
#define PG8_WAIT_L(n) asm volatile("s_waitcnt lgkmcnt(" #n ")" ::: "memory")
#define PG8_BAR __builtin_amdgcn_s_barrier()
#define PG8_SCHED __builtin_amdgcn_sched_barrier(0)
    Unit cur, nxt; int ui = 0;
    if (!S.next(0, cur)) return;
    f32x4 acc[2][2][4][2];
#pragma unroll
    for (int a = 0; a < 2; ++a)
#pragma unroll
        for (int b = 0; b < 2; ++b)
#pragma unroll
            for (int m = 0; m < 4; ++m)
#pragma unroll
                for (int n = 0; n < 2; ++n) acc[a][b][m][n] = (f32x4){0.f, 0.f, 0.f, 0.f};
    bf16x8 At[4][2], B0[2][2], B1[2][2];
    const char* cA = (const char*)g.A + (size_t)cur.pm * tstep; const char* cB = (const char*)g.Bt + (size_t)cur.pn * tstep;
    S.a_ready(cur);
    if constexpr (SP2) {
        PG8_STAGE(PG8_SB(0, 0), cB, voffB); PG8_STAGE(PG8_SB(0, 1), cB + hstep, voffB); PG8_STAGE(PG8_SA(0, 0), cA, voffA); PG8_STAGE(PG8_SA(0, 1), cA + hstep, voffA);
        if (wr == 1) PG8_BAR;
        PG8_WAIT_V(2); PG8_BAR;
        PG8_STAGE(PG8_SB(1, 0), cB + kstep, voffB); PG8_STAGE(PG8_SA(1, 0), cA + kstep, voffA); PG8_STAGE(PG8_SB(1, 1), cB + hstep + kstep, voffB);
        PG8_WAIT_V(6); PG8_BAR;
    } else {
        PG8_STAGE(PG8_SB(0, 0), cB, voffB); PG8_STAGE(PG8_SA(0, 0), cA, voffA); PG8_STAGE(PG8_SB(0, 1), cB + hstep, voffB); PG8_STAGE(PG8_SA(0, 1), cA + hstep, voffA);
        if (wr == 1) PG8_BAR;
        PG8_WAIT_V(4); PG8_BAR;
        PG8_STAGE(PG8_SB(1, 0), cB + kstep, voffB); PG8_STAGE(PG8_SA(1, 0), cA + kstep, voffA); PG8_STAGE(PG8_SB(1, 1), cB + hstep + kstep, voffB);
        PG8_WAIT_V(6); PG8_BAR;
    }
    for (;;) {
        const bool has_next = S.next(ui + 1, nxt);
        const char* nA = has_next ? (const char*)g.A + (size_t)nxt.pm * tstep : cA; const char* nB = has_next ? (const char*)g.Bt + (size_t)nxt.pn * tstep : cB;
        for (int t = 0; t < nt; t += 2) {
            const bool last = (t == nt - 2);
            const char* a1 = cA + (size_t)(t + 1) * kstep;
            const char* a2 = last ? nA : cA + (size_t)(t + 2) * kstep; const char* b2 = last ? nB : cB + (size_t)(t + 2) * kstep;
            const char* a3 = a2 + kstep; const char* b3 = b2 + kstep;
            if (last && has_next) S.a_ready(nxt);
            if constexpr (SP2) {
            PG8_LDB(B0, 0, 0); PG8_LDB(B1, 0, 1); PG8_SCHED; PG8_LDA(At, 0, 0); PG8_STAGE(PG8_SA(1, 1), a1 + hstep, voffA);
            PG8_WAIT_V(8); PG8_WAIT_L(0); PG8_BAR; PG8_MMA(0, 0, At, B0); PG8_MMA(0, 1, At, B1); PG8_BAR; PG8_SCHED;
            PG8_LDA(At, 0, 1); PG8_STAGE(PG8_SB(0, 0), b2, voffB); PG8_STAGE(PG8_SB(0, 1), b2 + hstep, voffB); PG8_STAGE(PG8_SA(0, 0), a2, voffA);
            PG8_WAIT_V(8); PG8_WAIT_L(0); PG8_BAR; PG8_MMA(1, 0, At, B0); PG8_MMA(1, 1, At, B1); PG8_BAR; PG8_SCHED;
            PG8_LDB(B0, 1, 0); PG8_LDB(B1, 1, 1); PG8_SCHED; PG8_LDA(At, 1, 0); PG8_STAGE(PG8_SA(0, 1), a2 + hstep, voffA);
            PG8_WAIT_V(8); PG8_WAIT_L(0); PG8_BAR; PG8_MMA(0, 0, At, B0); PG8_MMA(0, 1, At, B1); PG8_BAR; PG8_SCHED;
            PG8_LDA(At, 1, 1); PG8_STAGE(PG8_SB(1, 0), b3, voffB); PG8_STAGE(PG8_SB(1, 1), b3 + hstep, voffB); PG8_STAGE(PG8_SA(1, 0), a3, voffA);
            PG8_WAIT_V(8); PG8_WAIT_L(0); PG8_BAR; PG8_MMA(1, 0, At, B0); PG8_MMA(1, 1, At, B1); PG8_BAR; PG8_SCHED;
            } else {
            PG8_LDB(B0, 0, 0); PG8_SCHED; PG8_LDA(At, 0, 0); PG8_STAGE(PG8_SA(1, 1), a1 + hstep, voffA);
            PG8_WAIT_L(8); PG8_BAR; PG8_WAIT_L(0); PG8_MMA(0, 0, At, B0); PG8_BAR; PG8_SCHED;
            PG8_LDB(B1, 0, 1); PG8_STAGE(PG8_SB(0, 0), b2, voffB);
            PG8_BAR; PG8_WAIT_L(0); PG8_MMA(0, 1, At, B1); PG8_BAR;
            PG8_LDA(At, 0, 1); PG8_STAGE(PG8_SA(0, 0), a2, voffA);
            PG8_BAR; PG8_WAIT_L(0); PG8_MMA(1, 0, At, B0); PG8_BAR; PG8_SCHED;
            PG8_STAGE(PG8_SB(0, 1), b2 + hstep, voffB);
            PG8_WAIT_V(6); PG8_BAR; PG8_MMA(1, 1, At, B1); PG8_BAR;
            PG8_LDB(B0, 1, 0); PG8_SCHED; PG8_LDA(At, 1, 0); PG8_STAGE(PG8_SA(0, 1), a2 + hstep, voffA);
            PG8_WAIT_L(8); PG8_BAR; PG8_WAIT_L(0); PG8_MMA(0, 0, At, B0); PG8_BAR; PG8_SCHED;
            PG8_LDB(B1, 1, 1); PG8_STAGE(PG8_SB(1, 0), b3, voffB);
            PG8_BAR; PG8_WAIT_L(0); PG8_MMA(0, 1, At, B1); PG8_BAR;
            PG8_LDA(At, 1, 1); PG8_STAGE(PG8_SA(1, 0), a3, voffA);
            PG8_BAR; PG8_WAIT_L(0); PG8_MMA(1, 0, At, B0); PG8_BAR; PG8_SCHED;
            PG8_STAGE(PG8_SB(1, 1), b3 + hstep, voffB);
            PG8_WAIT_V(6); PG8_BAR; PG8_MMA(1, 1, At, B1); PG8_BAR;
            }
        }
        if constexpr (ALIGN_EPI) { if (wr == 0) PG8_BAR; }
        if constexpr (!Epi::AFTER_DRAIN) { E(acc, cur, wr, wc, fr, fq); S.done(cur); }
        if (!has_next) break;
#pragma unroll
        for (int a = 0; a < 2; ++a)
#pragma unroll
            for (int b = 0; b < 2; ++b)
#pragma unroll
                for (int m = 0; m < 4; ++m)
#pragma unroll
                    for (int n = 0; n < 2; ++n) acc[a][b][m][n] = (f32x4){0.f, 0.f, 0.f, 0.f};
        cur = nxt; cA = nA; cB = nB; ++ui;
        if constexpr (ALIGN_EPI) { if (wr == 1) PG8_BAR; }
    }
    PG8_WAIT_V(0);
    if constexpr (!ALIGN_EPI) { if (wr == 0) PG8_BAR; }
    PG8_BAR;
    if constexpr (Epi::AFTER_DRAIN) { E.fused(acc, cur, wr, wc, fr, fq, lds, wid, lane); S.done(cur); }
#undef PG8_SA
#undef PG8_SB
#undef PG8_STAGE
#undef PG8_LDA
#undef PG8_LDB
#undef PG8_MMA
#undef PG8_WAIT_V
#undef PG8_WAIT_L
#undef PG8_BAR
#undef PG8_SCHED
}
}

#ifndef PG8_SP2
#define PG8_SP2 true
#endif
#ifndef PG8_ALIGN
#define PG8_ALIGN true
#endif
#include <hip/hip_bf16.h>
#include <cmath>
namespace attn_body {
using bf16=__hip_bfloat16;
using bf16x8=__attribute__((ext_vector_type(8)))short;
using s16x4=__attribute__((ext_vector_type(4)))short;
using f32x16=__attribute__((ext_vector_type(16)))float;
using u32x4=__attribute__((ext_vector_type(4)))unsigned;
constexpr int BATCH=2,NHEAD=16,SEQ=8192,D=64,DM=NHEAD*D;
constexpr int NW=8,QBLK=32,QB=QBLK*NW,KVBLK=64,NQB=SEQ/QB;
constexpr int ATTN_PITCH=DM, ATTN_UNIT_ROWS=QB;
__device__ __forceinline__ int crow(int r,int hi){return (r&3)+8*(r>>2)+4*hi;}
#define SBAR() __builtin_amdgcn_sched_barrier(0)
__device__ __forceinline__ void cmask(f32x16&p0,f32x16&p1,int jb,int qrel,int hi){
  asm volatile("":"+v"(qrel));
  const float NEG=-INFINITY; int kb=64*jb+4*hi; asm volatile("":"+v"(kb));
  #pragma unroll
  for(int r=0;r<16;++r){int kv=kb+(r&3)+8*(r>>2); if(kv>qrel)p0[r]=NEG; if(kv+32>qrel)p1[r]=NEG;}
}

constexpr int NSLOT=3, SLOTB=8192;
constexpr int LDS_K=0, LDS_V=NSLOT*SLOTB, LDS_WS=2*NSLOT*SLOTB, LDS_OST=LDS_WS+NW*64*4, LDS_BYTES=LDS_OST+NW*4096;
constexpr float C2=0.125f*1.4426950408889634f;
__device__ __forceinline__ void glds16(const void*gsrc,unsigned lds_dst){unsigned keep;
  asm volatile("s_mov_b32 %0, m0\n\ts_mov_b32 m0, %2\n\ts_nop 0\n\tglobal_load_lds_dwordx4 %1, off\n\ts_mov_b32 m0, %0":"=&s"(keep):"v"(gsrc),"s"(lds_dst):"memory");}
__device__ __forceinline__ float max3f(float a,float b,float c){float r;asm("v_max3_f32 %0, %1, %2, %3":"=v"(r):"v"(a),"v"(b),"v"(c));return r;}
__device__ __forceinline__ float max2f(float a,float b){float r;asm("v_max_f32_e32 %0, %1, %2":"=v"(r):"v"(a),"v"(b));return r;}
__device__ __forceinline__ float fadd_s(float a,float b){float r;asm("v_add_f32_e32 %0, %1, %2":"=v"(r):"v"(a),"v"(b));return r;}
__device__ __forceinline__ float fsub_s(float a,float b){float r;asm("v_sub_f32_e32 %0, %1, %2":"=v"(r):"v"(a),"v"(b));return r;}
typedef float f32x2_t __attribute__((ext_vector_type(2))); typedef __bf16 bf16x2_t __attribute__((ext_vector_type(2)));
__device__ __forceinline__ unsigned cvtpk_s(float lo,float hi){f32x2_t v={lo,hi};bf16x2_t b=__builtin_convertvector(v,bf16x2_t);return __builtin_bit_cast(unsigned,b);}
#define WAIT_BAR(N) asm volatile("s_waitcnt vmcnt(" #N ") lgkmcnt(0)\n\ts_barrier":::"memory")

__device__ __forceinline__ void qkt(f32x16&p0,f32x16&p1,const char*Kslot,const bf16x8*qr,const f32x16&negm,int r32,int hi){
  const char*kb=Kslot+hi*1024+r32*16;
  #pragma unroll
  for(int d0=0;d0<4;++d0){
    const bf16x8 b0=*reinterpret_cast<const bf16x8*>(kb+d0*2048);
    const bf16x8 b1=*reinterpret_cast<const bf16x8*>(kb+d0*2048+512);
    if(d0==0){p0=__builtin_amdgcn_mfma_f32_32x32x16_bf16(b0,qr[0],negm,0,0,0);p1=__builtin_amdgcn_mfma_f32_32x32x16_bf16(b1,qr[0],negm,0,0,0);}
    else{p0=__builtin_amdgcn_mfma_f32_32x32x16_bf16(b0,qr[d0],p0,0,0,0);p1=__builtin_amdgcn_mfma_f32_32x32x16_bf16(b1,qr[d0],p1,0,0,0);}}
}
typedef __attribute__((address_space(3))) const char* lds_cptr;
typedef short v4i16_t __attribute__((ext_vector_type(4)));
__device__ __forceinline__ void kload8(bf16x8*kf,lds_cptr kp){
  kf[0]=*(const __attribute__((address_space(3))) bf16x8*)(kp);      kf[1]=*(const __attribute__((address_space(3))) bf16x8*)(kp+512);
  kf[2]=*(const __attribute__((address_space(3))) bf16x8*)(kp+2048); kf[3]=*(const __attribute__((address_space(3))) bf16x8*)(kp+2560);
  kf[4]=*(const __attribute__((address_space(3))) bf16x8*)(kp+4096); kf[5]=*(const __attribute__((address_space(3))) bf16x8*)(kp+4608);
  kf[6]=*(const __attribute__((address_space(3))) bf16x8*)(kp+6144); kf[7]=*(const __attribute__((address_space(3))) bf16x8*)(kp+6656);
}
__device__ __forceinline__ void kload2(bf16x8*kf,lds_cptr kp,int j){ kf[2*j]=*(const __attribute__((address_space(3))) bf16x8*)(kp+j*2048); kf[2*j+1]=*(const __attribute__((address_space(3))) bf16x8*)(kp+j*2048+512); }
__device__ __forceinline__ s16x4 vtr(lds_cptr p){ return __builtin_bit_cast(s16x4,__builtin_amdgcn_ds_read_tr16_b64_v4i16((__attribute__((address_space(3))) v4i16_t*)p)); }
__device__ __forceinline__ float rowmax(const f32x16&p0,const f32x16&p1){
  float a=max3f(p0[0],p0[1],p1[0]),b=max3f(p0[2],p0[3],p1[1]);a=max3f(a,p1[2],p1[3]);
  #pragma unroll
  for(int r=4;r<16;r+=4){a=max3f(a,p0[r],p0[r+1]);b=max3f(b,p0[r+2],p0[r+3]);a=max3f(a,p1[r],p1[r+1]);b=max3f(b,p1[r+2],p1[r+3]);}
  const float m=max2f(a,b);
  auto rr=__builtin_amdgcn_permlane32_swap(__float_as_uint(m),__float_as_uint(m),false,false);
  return max2f(__uint_as_float(rr[0]),__uint_as_float(rr[1]));
}
__device__ __forceinline__ void pv(f32x16*o,int vb,bf16x8 pa0,bf16x8 pa1,bf16x8 pa2,bf16x8 pa3){
  #pragma unroll
  for(int d0=0;d0<2;++d0){s16x4 lo[4],hi[4];
    #pragma unroll
    for(int ks=0;ks<4;++ks){
      asm volatile("ds_read_b64_tr_b16 %0,%1 offset:%c2":"=&v"(lo[ks]):"v"(vb),"i"(d0*4096+ks*1024):"memory");
      asm volatile("ds_read_b64_tr_b16 %0,%1 offset:%c2":"=&v"(hi[ks]):"v"(vb),"i"(d0*4096+ks*1024+512):"memory");}
    asm volatile("s_waitcnt lgkmcnt(0)":::"memory");SBAR();
    #define PK(k) (bf16x8){lo[k][0],lo[k][1],lo[k][2],lo[k][3],hi[k][0],hi[k][1],hi[k][2],hi[k][3]}
    o[d0]=__builtin_amdgcn_mfma_f32_32x32x16_bf16(pa0,PK(0),o[d0],0,0,0);
    o[d0]=__builtin_amdgcn_mfma_f32_32x32x16_bf16(pa1,PK(1),o[d0],0,0,0);
    o[d0]=__builtin_amdgcn_mfma_f32_32x32x16_bf16(pa2,PK(2),o[d0],0,0,0);
    o[d0]=__builtin_amdgcn_mfma_f32_32x32x16_bf16(pa3,PK(3),o[d0],0,0,0);
    #undef PK
  }
}

#ifndef ATTN_STORE16
#define ATTN_STORE16(p,v) (*(u32x4*)(p)=(v))
#endif
template<int THRL> __device__ __forceinline__ void attn_unit(int b,int h,int qb,const bf16*Q,const bf16*__restrict__ K,const bf16*__restrict__ V,bf16*O,char*shm){
  const int tid=threadIdx.x,lane=tid&63,r32=lane&31,hi=lane>>5; const int wid=__builtin_amdgcn_readfirstlane(tid>>6);
  const long rowbase=(long)b*SEQ; const int q0=qb*QB;
  const bf16*Qw=Q+(rowbase+q0+wid*QBLK)*DM+h*D;
  const bf16*Kh=K+rowbase*DM+h*D,*Vh=V+rowbase*DM+h*D;
  const unsigned lds0=(unsigned)(uintptr_t)shm;
  float*wsf=(float*)(shm+LDS_WS)+wid*64;
  const bf16*ksrc=Kh+(long)lane*DM+wid*8;
  const bf16*vsrc=Vh+(long)(16*(wid&3)+(lane>>2))*DM+(wid>>2)*32+(lane&3)*8;
  const unsigned kdst=lds0+LDS_K+wid*1024, vdst=lds0+LDS_V+wid*1024;
  #define DMA_K(t,slot) glds16(ksrc+(long)(t)*KVBLK*DM,(unsigned)__builtin_amdgcn_readfirstlane(kdst+(slot)))
  #define DMA_V(t,slot) glds16(vsrc+(long)(t)*KVBLK*DM,(unsigned)__builtin_amdgcn_readfirstlane(vdst+(slot)))
  const int vb0=(int)(lds0+LDS_V)+((lane>>4)&1)*32+(lane&3)*8+(4*hi+((lane&15)>>2))*64;
  const char*Kbase=shm+LDS_K; bf16x8 kf[8];
  const lds_cptr shm3=(lds_cptr)shm; const lds_cptr kp0=shm3+LDS_K+hi*1024+r32*16; const lds_cptr vp0=shm3+LDS_V+((lane>>4)&1)*32+(lane&3)*8+(4*hi+((lane&15)>>2))*64;
  const int NT=(q0+QB)/KVBLK;
  DMA_K(0,0);DMA_V(0,0);DMA_K(1,SLOTB);
  bf16x8 qr[4];
  #pragma unroll
  for(int d0=0;d0<4;++d0)qr[d0]=*reinterpret_cast<const bf16x8*>(&Qw[(long)r32*DM+d0*16+hi*8]);
  float mhat=0.f,l_reg=0.f;f32x16 o[2];o[0]=f32x16{};o[1]=f32x16{};f32x16 negm=f32x16{};asm volatile("":"+v"(negm));
  const int qrel=wid*QBLK+r32;
  #define CMASK(P0,P1,t) do{int jb_=(t)-(NT-4); if(jb_>=0)cmask(P0,P1,jb_,qrel,hi);}while(0)
  bool resc=false;
  #define START(P0,P1) do{ const float rm=rowmax(P0,P1); resc=false; \
    { const float dl=rm; mhat=fadd_s(mhat,dl); \
      _Pragma("unroll") for(int r=0;r<16;++r){P0[r]=fsub_s(P0[r],dl);P1[r]=fsub_s(P1[r],dl);} \
      _Pragma("unroll") for(int r=0;r<16;++r)negm[r]=-mhat; asm volatile("":"+v"(negm)); } \
    _Pragma("unroll") for(int r=0;r<16;++r)P0[r]=__builtin_amdgcn_exp2f(P0[r]); }while(0)
  #define RESC() do{ if(resc){ asm volatile("s_waitcnt lgkmcnt(0)":::"memory"); \
      _Pragma("unroll") for(int d_=0;d_<2;++d_) _Pragma("unroll") for(int r=0;r<16;++r)o[d_][r]*=wsf[crow(r,hi)]; } }while(0)
  f32x16 pA0,pA1,pB0,pB1;
  int sl_prev=0,sl_cur=0,sl_next=SLOTB;
  #define ROT() do{sl_prev=sl_cur;sl_cur=sl_next;sl_next=(sl_next==(NSLOT-1)*SLOTB)?0:sl_next+SLOTB;}while(0)
  DMA_K(2,2*SLOTB);
  WAIT_BAR(3);
  qkt(pA0,pA1,Kbase,qr,negm,r32,hi);asm volatile("s_nop 15\n\ts_nop 7":"+v"(pA0),"+v"(pA1));CMASK(pA0,pA1,0);
  START(pA0,pA1);
  _Pragma("unroll") for(int r=0;r<16;++r)pA1[r]=__builtin_amdgcn_exp2f(pA1[r]);
  WAIT_BAR(0);
  DMA_K(3,0);DMA_V(1,SLOTB);
  ROT();
  kload8(kf,kp0+sl_cur);
  WAIT_BAR(2);
  s16x4 vlo[8],vhi[8]; u32x4 pw0,pw1,pw2,pw3;
  #define PKW(P,B) cvtpk_s(P[B],P[B+1])
  #define PAF(k) __builtin_bit_cast(bf16x8,pw##k)
  #define VFR(i) (bf16x8){vlo[i][0],vlo[i][1],vlo[i][2],vlo[i][3],vhi[i][0],vhi[i][1],vhi[i][2],vhi[i][3]}
  #define PIN(x) asm volatile("":"+v"(x))
  #define MX3(a,b,c) __builtin_fmaxf(__builtin_fmaxf((a),(b)),(c))
  #define GAPA(MF,A0,A1,A2,A3,W0,W1,PW) do{ MF; sacc+=A0; sacc+=A1; sacc+=A2; sacc+=A3; PIN(sacc); W0; W1; PIN(PW); SBAR(); }while(0)
  #define EX(v) __builtin_amdgcn_exp2f(v)
  #define GAPB(MF,X,B) do{ MF; X[B]=EX(X[B]); X[B+1]=EX(X[B+1]); X[B+2]=EX(X[B+2]); X[B+3]=EX(X[B+3]); PIN(X); SBAR(); }while(0)
  #define VRD(i) do{ vlo[i]=vtr(vp_+(((i)>>2)*4096+((i)&3)*1024)); vhi[i]=vtr(vp_+(((i)>>2)*4096+((i)&3)*1024+512)); }while(0)
  #define KRD(G,j) do{ if(G){ kload2(kf,kp0+sl_next,j); SBAR(); } }while(0)
  #define STEP(C0,C1,P0,P1,t,GK,GV,GL) do{ SBAR(); \
    const lds_cptr vp_=vp0+sl_prev; \
    VRD(0); SBAR(); float sacc=(P0[0]+P0[1]); \
    GAPA(C0=__builtin_amdgcn_mfma_f32_32x32x16_bf16(kf[0],qr[0],negm,0,0,0), P0[2],P0[3],P0[4],P0[5],     pw0[0]=PKW(P0,0), pw0[1]=PKW(P0,2), pw0); \
    VRD(4); SBAR(); GAPA(C1=__builtin_amdgcn_mfma_f32_32x32x16_bf16(kf[1],qr[0],negm,0,0,0), P0[6],P0[7],P0[8],P0[9],     pw0[2]=PKW(P0,4), pw0[3]=PKW(P0,6), pw0); \
    VRD(1); SBAR(); GAPA(C0=__builtin_amdgcn_mfma_f32_32x32x16_bf16(kf[2],qr[1],C0,0,0,0),   P0[10],P0[11],P0[12],P0[13], pw1[0]=PKW(P0,8), pw1[1]=PKW(P0,10), pw1); \
    VRD(5); SBAR(); GAPA(C1=__builtin_amdgcn_mfma_f32_32x32x16_bf16(kf[3],qr[1],C1,0,0,0),   P0[14],P0[15],P1[0],P1[1],   pw1[2]=PKW(P0,12),pw1[3]=PKW(P0,14), pw1); \
    VRD(2); SBAR(); GAPA(C0=__builtin_amdgcn_mfma_f32_32x32x16_bf16(kf[4],qr[2],C0,0,0,0),   P1[2],P1[3],P1[4],P1[5],     pw2[0]=PKW(P1,0), pw2[1]=PKW(P1,2), pw2); \
    VRD(6); SBAR(); GAPA(C1=__builtin_amdgcn_mfma_f32_32x32x16_bf16(kf[5],qr[2],C1,0,0,0),   P1[6],P1[7],P1[8],P1[9],     pw2[2]=PKW(P1,4), pw2[3]=PKW(P1,6), pw2); \
    VRD(3); SBAR(); GAPA(C0=__builtin_amdgcn_mfma_f32_32x32x16_bf16(kf[6],qr[3],C0,0,0,0),   P1[10],P1[11],P1[12],P1[13], pw3[0]=PKW(P1,8), pw3[1]=PKW(P1,10), pw3); \
    VRD(7); SBAR(); GAPA(C1=__builtin_amdgcn_mfma_f32_32x32x16_bf16(kf[7],qr[3],C1,0,0,0),   P1[14],P1[15],0.f,0.f,       pw3[2]=PKW(P1,12),pw3[3]=PKW(P1,14), pw3); \
    l_reg+=sacc; \
    if(GK){DMA_K((t)+3,sl_cur);} if(GV){DMA_V((t)+1,sl_next);} \
    CMASK(C0,C1,t); \
    { float a=MX3(C0[0],C0[1],C1[0]),b=MX3(C0[2],C0[3],C1[1]); a=MX3(a,C1[2],C1[3]); \
      _Pragma("unroll") for(int r=4;r<16;r+=4){a=MX3(a,C0[r],C0[r+1]);b=MX3(b,C0[r+2],C0[r+3]);a=MX3(a,C1[r],C1[r+1]);b=MX3(b,C1[r+2],C1[r+3]);} \
      float rm=__builtin_fmaxf(a,b); { auto rr=__builtin_amdgcn_permlane32_swap(__float_as_uint(rm),__float_as_uint(rm),false,false); rm=__builtin_fmaxf(__uint_as_float(rr[0]),__uint_as_float(rr[1])); } \
      resc=false; \
      if(__builtin_expect(__any(rm>(float)THRL),0)){ const float dl=__builtin_fmaxf(rm,0.f); mhat+=dl; \
        _Pragma("unroll") for(int r=0;r<16;++r){C0[r]-=dl;C1[r]-=dl;} \
        _Pragma("unroll") for(int r=0;r<16;++r)negm[r]=-mhat; asm volatile("":"+v"(negm)); \
        const float f=__builtin_amdgcn_exp2f(-dl); l_reg*=f; if(hi==0)wsf[r32]=f; resc=true; } } \
    SBAR(); \
    GAPB(o[0]=__builtin_amdgcn_mfma_f32_32x32x16_bf16(PAF(0),VFR(0),o[0],0,0,0), C0,0); \
    GAPB(o[1]=__builtin_amdgcn_mfma_f32_32x32x16_bf16(PAF(0),VFR(4),o[1],0,0,0), C0,4); \
    KRD(GL,0); GAPB(o[0]=__builtin_amdgcn_mfma_f32_32x32x16_bf16(PAF(1),VFR(1),o[0],0,0,0), C0,8); \
    KRD(GL,1); GAPB(o[1]=__builtin_amdgcn_mfma_f32_32x32x16_bf16(PAF(1),VFR(5),o[1],0,0,0), C0,12); \
    KRD(GL,2); GAPB(o[0]=__builtin_amdgcn_mfma_f32_32x32x16_bf16(PAF(2),VFR(2),o[0],0,0,0), C1,0); \
    KRD(GL,3); GAPB(o[1]=__builtin_amdgcn_mfma_f32_32x32x16_bf16(PAF(2),VFR(6),o[1],0,0,0), C1,4); \
    GAPB(o[0]=__builtin_amdgcn_mfma_f32_32x32x16_bf16(PAF(3),VFR(3),o[0],0,0,0), C1,8); \
    GAPB(o[1]=__builtin_amdgcn_mfma_f32_32x32x16_bf16(PAF(3),VFR(7),o[1],0,0,0), C1,12); \
    }while(0)
  int t=1;
  #undef CMASK
  #define CMASK(P0,P1,t) do{}while(0)
  for(;t+5<NT;t+=2){
    STEP(pB0,pB1,pA0,pA1,t,true,true,true);     WAIT_BAR(2); RESC(); ROT();
    STEP(pA0,pA1,pB0,pB1,t+1,true,true,true);   WAIT_BAR(2); RESC(); ROT();
  }
  #undef CMASK
  #define CMASK(P0,P1,t) do{int jb_=(t)-(NT-4); if(jb_>=0)cmask(P0,P1,jb_,qrel,hi);}while(0)
  #define ENDW(tt) do{ if((tt)+3<NT){WAIT_BAR(2);} else if((tt)+2<NT){WAIT_BAR(1);} else {WAIT_BAR(0);} }while(0)
  for(;t+1<NT;t+=2){
    STEP(pB0,pB1,pA0,pA1,t,(t+3<NT),(t+1<NT),(t+1<NT));       ENDW(t);   RESC(); ROT();
    STEP(pA0,pA1,pB0,pB1,t+1,(t+4<NT),(t+2<NT),(t+2<NT));     ENDW(t+1); RESC(); ROT();
  }
  STEP(pB0,pB1,pA0,pA1,NT-1,false,false,false); RESC();
  { float sacc=pB0[0]+pB0[1]; _Pragma("unroll") for(int r=2;r<16;++r)sacc+=pB0[r]; _Pragma("unroll") for(int r=0;r<16;++r)sacc+=pB1[r]; l_reg+=sacc;
    pw0=(u32x4){PKW(pB0,0),PKW(pB0,2),PKW(pB0,4),PKW(pB0,6)};pw1=(u32x4){PKW(pB0,8),PKW(pB0,10),PKW(pB0,12),PKW(pB0,14)};pw2=(u32x4){PKW(pB1,0),PKW(pB1,2),PKW(pB1,4),PKW(pB1,6)};pw3=(u32x4){PKW(pB1,8),PKW(pB1,10),PKW(pB1,12),PKW(pB1,14)};
    SBAR(); pv(o,vb0+sl_cur,PAF(0),PAF(1),PAF(2),PAF(3)); }
  #undef PKW
  #undef PAF
  #undef VFR
  #undef PIN
  #undef MX3
  #undef GAPA
  #undef GAPB
  #undef EX
  #undef VRD
  #undef KRD
  #undef STEP
  #undef ENDW
  {auto rr=__builtin_amdgcn_permlane32_swap(__float_as_uint(l_reg),__float_as_uint(l_reg),false,false);l_reg=__uint_as_float(rr[0])+__uint_as_float(rr[1]);}
  if(hi==0)wsf[32+r32]=l_reg;asm volatile("s_waitcnt lgkmcnt(0)":::"memory");
  float rli[16];
  #pragma unroll
  for(int r=0;r<16;++r)rli[r]=__builtin_amdgcn_rcpf(wsf[32+crow(r,hi)]);
  bf16*Ow=O+(rowbase+q0+wid*QBLK)*DM+h*D;
  { bf16*stg=(bf16*)(shm+LDS_OST)+wid*2048;
    #pragma unroll
    for(int r=0;r<16;++r){const int orow=crow(r,hi);
      #pragma unroll
      for(int d0=0;d0<2;++d0)stg[orow*64+d0*32+r32]=__float2bfloat16(o[d0][r]*rli[r]);}
    asm volatile("s_waitcnt lgkmcnt(0)":::"memory");
    #pragma unroll
    for(int i=0;i<4;++i){const int row=i*8+(lane>>3),ch=lane&7; const u32x4 v=*(const u32x4*)(stg+row*64+ch*8); ATTN_STORE16(Ow+(long)row*DM+ch*8,v);} }
  asm volatile("s_waitcnt lgkmcnt(0)\n\ts_barrier":::"memory");
  #undef DMA_K
  #undef DMA_V
  #undef CMASK
  #undef START
  #undef RESC
  #undef ROT
}
constexpr int ATTN_LDS_BYTES=LDS_BYTES;
typedef __attribute__((address_space(3))) char* lds_ptr;
constexpr int MIXA_K=0, MIXA_V=49152, MIXA_WS=98304, MIXA_ST=100352, MIXA_LDS_BYTES=MIXA_ST+NW*4096;
#define LDSP(T) __attribute__((address_space(3))) T*
__device__ __forceinline__ void mixa_issue(u32x4(&kr)[6],u32x4(&vr)[6],bf16x8(&qn)[4],int uu,int dil,const bf16*Q,const bf16*K,const bf16*V,int wid,int lane){
  const int bh=uu>>5,q=uu&31,b=bh>>4,h=bh&15,res=q%dil,blk=q/dil; const long pitch=(long)dil*DM; const long tok0=(long)b*SEQ+res; const int i0=blk*256;
  const long roff=(long)(i0-128+wid*8+(lane&7))*pitch+(lane>>3)*8;
  const bf16*kp=K+tok0*DM+h*D+roff; const bf16*vp=V+tok0*DM+h*D+roff;
  #pragma unroll
  for(int jt=0;jt<6;++jt){ if(jt>=2||blk!=0){ kr[jt]=*(const u32x4*)(kp+(long)(64*jt)*pitch); vr[jt]=*(const u32x4*)(vp+(long)(64*jt)*pitch); } }
  const bf16*Qb=Q+tok0*DM+h*D; const int qlo=i0+wid*32,r32=lane&31,hi=lane>>5;
  #pragma unroll
  for(int d0=0;d0<4;++d0)qn[d0]=*reinterpret_cast<const bf16x8*>(&Qb[(long)(qlo+r32)*pitch+d0*16+hi*8]);
}
__device__ __forceinline__ void mixa_phase(int pat,int dil,int vcu,int G,const bf16*Q,const bf16*K,const bf16*V,bf16*Ost,float*Mst,float*Lst,char*shm){
  const int tid=threadIdx.x,lane=tid&63,r32=lane&31,hi=lane>>5; const int wid=__builtin_amdgcn_readfirstlane(tid>>6);
  const long pitch=(long)dil*DM;
  const unsigned lds0=(unsigned)(uintptr_t)shm; const lds_ptr L=(lds_ptr)shm;
  LDSP(float) wsf=(LDSP(float))(L+MIXA_WS)+wid*64;
  LDSP(unsigned short) stg=(LDSP(unsigned short))(L+MIXA_ST)+wid*2048;
  const int vb0=(int)(lds0+MIXA_V)+((lane>>4)&1)*32+(lane&3)*8+(4*hi+((lane&15)>>2))*64;
  u32x4 kr[6],vr[6]; bf16x8 qn[4];
  const int kdst=(lane>>3)*1024+(wid*8+(lane&7))*16;
  const int vdst=((lane>>3)>>2)*4096+(wid>>1)*1024+((wid&1)*8+(lane&7))*64+((lane>>3)&3)*16;
  int uu=vcu*4;
  if(uu<1024)mixa_issue(kr,vr,qn,uu,dil,Q,K,V,wid,lane);
  while(uu<1024){
    const int bh=uu>>5,q=uu&31,b=bh>>4,h=bh&15,res=q%dil,blk=q/dil; const long tok0=(long)b*SEQ+res; const int i0=blk*256,qlo=i0+wid*32,jt0=(blk==0)?2:0;
    bf16*Ob=Ost+tok0*DM+h*D;
    __syncthreads();
    #pragma unroll
    for(int jt=0;jt<6;++jt){ if(jt>=jt0){ *(LDSP(u32x4))(L+MIXA_K+jt*8192+kdst)=kr[jt]; *(LDSP(u32x4))(L+MIXA_V+jt*8192+vdst)=vr[jt]; } }
    __syncthreads();
    bf16x8 qr[4];
    #pragma unroll
    for(int d0=0;d0<4;++d0)qr[d0]=qn[d0];
    const int un=((uu&3)==3)?uu+G*4-3:uu+1;
    if(un<1024)mixa_issue(kr,vr,qn,un,dil,Q,K,V,wid,lane);
    float m_run,l_reg; f32x16 o[2];
    const long grow=tok0+(long)dil*(qlo+r32);
    if(pat==0){ m_run=0.f; l_reg=0.f; o[0]=f32x16{}; o[1]=f32x16{}; }
    else{
      m_run=Mst[grow*16+h]; const float lf=Lst[grow*16+h]; l_reg=(hi==0)?lf:0.f;
      #pragma unroll
      for(int i=0;i<4;++i){const int row=i*8+(lane>>3),ch=lane&7; const u32x4 v=*(const u32x4*)(Ob+(long)(qlo+row)*pitch+ch*8); *(LDSP(u32x4))(stg+row*64+ch*8)=v;}
      if(hi==0)wsf[32+r32]=lf;
      asm volatile("s_waitcnt lgkmcnt(0)":::"memory");
      #pragma unroll
      for(int r=0;r<16;++r){const int orow=crow(r,hi); const float lr=wsf[32+orow];
        #pragma unroll
        for(int d0=0;d0<2;++d0)o[d0][r]=__uint_as_float(((unsigned)stg[orow*64+d0*32+r32])<<16)*lr;}
      asm volatile("s_waitcnt lgkmcnt(0)":::"memory");
    }
    const int qi=qlo+r32;
    #pragma unroll
    for(int c=0;c<3;++c){
      const int jt=(wid>>1)+c;
      if(jt>=jt0){
      const int j0=i0-128+64*jt;
      f32x16 p0,p1; const f32x16 zero=f32x16{};
      qkt(p0,p1,(const char*)shm+MIXA_K+jt*8192,qr,zero,r32,hi);
      #pragma unroll
      for(int r=0;r<16;++r){p0[r]-=m_run;p1[r]-=m_run;}
      if(c==0){ int lim=qi-128-j0-4*hi; asm volatile("":"+v"(lim));
        #pragma unroll
        for(int r=0;r<16;++r){ if((r&3)+8*(r>>2)<lim)p0[r]=-1e30f; if((r&3)+8*(r>>2)+32<lim)p1[r]=-1e30f; } }
      if(c==2){ int lim=qi-j0-4*hi; asm volatile("":"+v"(lim));
        #pragma unroll
        for(int r=0;r<16;++r){ if((r&3)+8*(r>>2)>lim)p0[r]=-1e30f; if((r&3)+8*(r>>2)+32>lim)p1[r]=-1e30f; } }
      float rm=__builtin_fmaxf(__builtin_fmaxf(p0[0],p0[1]),p0[2]);
      #pragma unroll
      for(int r=3;r<15;r+=2)rm=__builtin_fmaxf(__builtin_fmaxf(rm,p0[r]),p0[r+1]);
      rm=__builtin_fmaxf(__builtin_fmaxf(rm,p0[15]),p1[0]);
      #pragma unroll
      for(int r=1;r<15;r+=2)rm=__builtin_fmaxf(__builtin_fmaxf(rm,p1[r]),p1[r+1]);
      rm=__builtin_fmaxf(rm,p1[15]);
      { auto rr=__builtin_amdgcn_permlane32_swap(__float_as_uint(rm),__float_as_uint(rm),false,false); rm=__builtin_fmaxf(__uint_as_float(rr[0]),__uint_as_float(rr[1])); }
      if(__any(rm>8.f)){
        const float dl=__builtin_fmaxf(rm,0.f); const float alpha=__builtin_amdgcn_exp2f(-dl); m_run+=dl;
        l_reg*=alpha;
        #pragma unroll
        for(int r=0;r<16;++r){p0[r]-=dl;p1[r]-=dl;}
        if(hi==0)wsf[r32]=alpha;
        asm volatile("s_waitcnt lgkmcnt(0)":::"memory");
        #pragma unroll
        for(int r=0;r<16;++r){const float a=wsf[crow(r,hi)]; o[0][r]*=a; o[1][r]*=a;}
        asm volatile("s_waitcnt lgkmcnt(0)":::"memory");
      }
      float sacc=0.f;
      #pragma unroll
      for(int r=0;r<16;++r){p0[r]=__builtin_amdgcn_exp2f(p0[r]);p1[r]=__builtin_amdgcn_exp2f(p1[r]);sacc+=p0[r]+p1[r];}
      l_reg+=sacc;
      u32x4 pw0,pw1,pw2,pw3;
      pw0=(u32x4){cvtpk_s(p0[0],p0[1]),cvtpk_s(p0[2],p0[3]),cvtpk_s(p0[4],p0[5]),cvtpk_s(p0[6],p0[7])};
      pw1=(u32x4){cvtpk_s(p0[8],p0[9]),cvtpk_s(p0[10],p0[11]),cvtpk_s(p0[12],p0[13]),cvtpk_s(p0[14],p0[15])};
      pw2=(u32x4){cvtpk_s(p1[0],p1[1]),cvtpk_s(p1[2],p1[3]),cvtpk_s(p1[4],p1[5]),cvtpk_s(p1[6],p1[7])};
      pw3=(u32x4){cvtpk_s(p1[8],p1[9]),cvtpk_s(p1[10],p1[11]),cvtpk_s(p1[12],p1[13]),cvtpk_s(p1[14],p1[15])};
      pv(o,vb0+jt*8192,__builtin_bit_cast(bf16x8,pw0),__builtin_bit_cast(bf16x8,pw1),__builtin_bit_cast(bf16x8,pw2),__builtin_bit_cast(bf16x8,pw3));
      }
    }
    {auto rr=__builtin_amdgcn_permlane32_swap(__float_as_uint(l_reg),__float_as_uint(l_reg),false,false);l_reg=__uint_as_float(rr[0])+__uint_as_float(rr[1]);}
    if(hi==0){ Mst[grow*16+h]=m_run; Lst[grow*16+h]=l_reg; wsf[32+r32]=l_reg; }
    asm volatile("s_waitcnt lgkmcnt(0)":::"memory");
    #pragma unroll
    for(int r=0;r<16;++r){const int orow=crow(r,hi); const float rl=__builtin_amdgcn_rcpf(wsf[32+orow]);
      #pragma unroll
      for(int d0=0;d0<2;++d0){ const __hip_bfloat16 hb=__float2bfloat16(o[d0][r]*rl); stg[orow*64+d0*32+r32]=__builtin_bit_cast(unsigned short,hb); } }
    asm volatile("s_waitcnt lgkmcnt(0)":::"memory");
    #pragma unroll
    for(int i=0;i<4;++i){const int row=i*8+(lane>>3),ch=lane&7; const u32x4 v=*(const LDSP(u32x4))(stg+row*64+ch*8); *(u32x4*)(Ob+(long)(qlo+row)*pitch+ch*8)=v;}
    asm volatile("s_waitcnt lgkmcnt(0)":::"memory");
    uu=un;
  }
  __syncthreads();
}
#undef LDSP
#undef SBAR
#undef WAIT_BAR
}
constexpr int NWAVES = 8;
#ifndef PHM
#define PHM 0xfff
#endif
#ifndef MK_COOP
#define MK_COOP 1
#endif
#ifndef LAYER_LOOP
#define LAYER_LOOP 0
#endif
constexpr int BATCH = 2, T = 8192, D = 1024, M = BATCH * T, DEPTH = 2, NIN = 10240;
constexpr float RMS_EPS = 1e-6f, SUBLN_EPS = 1e-5f;
constexpr int PH_PER_LAYER = 11, N_PHASES = DEPTH * PH_PER_LAYER + 1;

constexpr size_t MiB = 1u << 20;
constexpr size_t WS_CS = 1 * MiB;
constexpr size_t WS_W = 2 * MiB, W_LAYER = 26 * MiB;
constexpr size_t W_A = 20 * MiB, W_B = 22 * MiB, W_O = 24 * MiB;
constexpr size_t WS_S = 54 * MiB, SLOT = 32 * MiB;
constexpr size_t WS_ML = WS_S + 8 * SLOT;
constexpr size_t WS_END = WS_ML + 2 * MiB;
constexpr int LDS_BYTES = 147456;

#define GAS __attribute__((address_space(1)))
#define LAS __attribute__((address_space(3)))
typedef unsigned short bf16;
typedef unsigned v4u __attribute__((ext_vector_type(4)));
typedef float f32x4 __attribute__((ext_vector_type(4)));
#define LDS_WAIT() asm volatile("s_waitcnt lgkmcnt(0)" ::: "memory")
__device__ __forceinline__ unsigned f2bf(float f) { unsigned u = __builtin_bit_cast(unsigned, f); return (u + 0x7fffu + ((u >> 16) & 1u)) >> 16; }
__device__ __forceinline__ unsigned pk2(float lo, float hi) { return f2bf(lo) | (f2bf(hi) << 16); }
__device__ __forceinline__ float wave_sum(float v) {
#pragma unroll
    for (int o = 1; o < 64; o <<= 1) v += __shfl_xor(v, o);
    return v;
}
typedef GAS unsigned gu32;
typedef GAS unsigned long long gu64;
#define RLX_AGENT __ATOMIC_RELAXED, __HIP_MEMORY_SCOPE_AGENT
#define VM_WAIT() asm volatile("s_waitcnt vmcnt(0)" ::: "memory")
#define XB_TMO      128
#define XB_XCNT(j)  (256  + 64 * (j))
#define XB_XSUB(j)  (1280 + 64 * (j))
#define XB_XGEN(j)  (2304 + 64 * (j))
#define XB_TOP      3328
#define XB_TOPGEN   3392
#define XCD_BAR_WORDS 3456
#define XB_SPIN_CAP (1u << 18)

__device__ __forceinline__ unsigned xb_ld(unsigned* p)              { return __hip_atomic_load(p, __ATOMIC_RELAXED, __HIP_MEMORY_SCOPE_AGENT); }
__device__ __forceinline__ unsigned xb_add(unsigned* p, unsigned v) { return __hip_atomic_fetch_add(p, v, __ATOMIC_RELAXED, __HIP_MEMORY_SCOPE_AGENT); }
__device__ __forceinline__ unsigned xb_xcc_id() { return (unsigned)__builtin_amdgcn_s_getreg((3 << 11) | 20) & 0xFu; }
#define XB_SPIN(cond, bar) do { unsigned _sp = 0; while (cond) { __builtin_amdgcn_s_sleep(1); \
    if ((++_sp & 255u) == 0u) { if (xb_ld(&(bar)[XB_TMO])) break; if (_sp > XB_SPIN_CAP) { atomicAdd(&(bar)[XB_TMO], 1u); break; } } } } while (0)

struct XcdBarrier {
    unsigned* bar; unsigned x;
    volatile LAS unsigned* st;
};

__device__ __forceinline__ XcdBarrier xcd_barrier_post(unsigned* bar, volatile LAS unsigned* st) {
    XcdBarrier b; b.bar = bar; b.x = xb_xcc_id(); b.st = st;
    if (threadIdx.x == 0) (void)xb_add(&bar[XB_XCNT(b.x)], 1u);
    return b;
}
__device__ __forceinline__ void xcd_barrier_complete(unsigned* bar, unsigned x, unsigned& nloc, unsigned& nx) {
    const unsigned G = gridDim.x * gridDim.y * gridDim.z;
    unsigned sum, cnt, mine, sp = 0u;
    for (;;) {
        sum = 0u; cnt = 0u; mine = 0u;
#pragma unroll
        for (unsigned j = 0; j < 16; ++j) { const unsigned c = xb_ld(&bar[XB_XCNT(j)]); sum += c; cnt += (c > 0u) ? 1u : 0u; mine = (j == x) ? c : mine; }
        if (sum == G) break;
        __builtin_amdgcn_s_sleep(1);
        if ((++sp & 255u) == 0u) { if (xb_ld(&bar[XB_TMO])) break; if (sp > XB_SPIN_CAP) { atomicAdd(&bar[XB_TMO], 1u); break; } }
    }
    nloc = mine > 0u ? mine : 1u; nx = cnt > 0u ? cnt : 1u;
}

__device__ __forceinline__ void xcd_barrier(const XcdBarrier& b) {
    asm volatile("s_waitcnt vmcnt(0)" ::: "memory");
    __syncthreads();
    if (threadIdx.x == 0) {
        unsigned* bar = b.bar;
        __builtin_amdgcn_s_waitcnt(0);
        unsigned nloc = b.st[0], nx = b.st[1];
        if (nloc == 0u) { xcd_barrier_complete(bar, b.x, nloc, nx); b.st[0] = nloc; b.st[1] = nx; }
        const unsigned old = xb_add(&bar[XB_XSUB(b.x)], 1u);
        const unsigned gen = old / nloc;
        if (old + 1u == (gen + 1u) * nloc) {
            __builtin_amdgcn_fence(__ATOMIC_RELEASE, "agent");
            asm volatile("s_waitcnt vmcnt(0)" ::: "memory");
            const unsigned og = xb_add(&bar[XB_TOP], 1u);
            const unsigned tg = og / nx;
            if (og + 1u == (tg + 1u) * nx) xb_add(&bar[XB_TOPGEN], 1u);
            else XB_SPIN(xb_ld(&bar[XB_TOPGEN]) == tg, bar);
            __builtin_amdgcn_fence(__ATOMIC_ACQUIRE, "agent");
            xb_add(&bar[XB_XGEN(b.x)], 1u);
            asm volatile("s_waitcnt vmcnt(0)" ::: "memory");
        } else {
            XB_SPIN(xb_ld(&bar[XB_XGEN(b.x)]) == gen, bar);
            __builtin_amdgcn_fence(__ATOMIC_ACQUIRE, "agent");
            asm volatile("s_waitcnt vmcnt(0)" ::: "memory");
        }
    }
    __syncthreads();
}

constexpr int MISC_OFF = LDS_BYTES - 256;
constexpr size_t CTL_ZERO_BYTES = 65536;
__device__ __forceinline__ void transpose_item(const float* W, int K, int ldw, int nblk, bf16* WT, int row_off, LAS float* scr, int item, int lane) {
    const int kb = item / nblk, nb = item % nblk, k0 = 64 * kb, n0 = 32 * nb;
#pragma unroll 8
    for (int i = 0; i < 32; ++i) { const int kk = 2 * i + (lane >> 5); scr[kk * 33 + (lane & 31)] = W[(size_t)(k0 + kk) * ldw + n0 + (lane & 31)]; }
    LDS_WAIT(); asm volatile("" ::: "memory");
    const int c = lane & 7;
#pragma unroll
    for (int j = 0; j < 4; ++j) { const int n = (lane >> 3) + 8 * j; const LAS float* s = scr + (8 * c) * 33 + n;
        v4u o; o.x = pk2(s[0 * 33], s[1 * 33]); o.y = pk2(s[2 * 33], s[3 * 33]); o.z = pk2(s[4 * 33], s[5 * 33]); o.w = pk2(s[6 * 33], s[7 * 33]);
        *(v4u*)(WT + (size_t)(row_off + n0 + n) * K + k0 + 8 * c) = o; }
    LDS_WAIT(); asm volatile("" ::: "memory");
}
__device__ __forceinline__ void rms_row_to_bf16(const float* xrow, const float* w, bf16* orow, int lane) {
    const f32x4* xr = (const f32x4*)xrow + lane; const f32x4* wr = (const f32x4*)w + lane;
    f32x4 v[4]; float s = 0.f;
#pragma unroll
    for (int j = 0; j < 4; ++j) { v[j] = xr[64 * j]; s += (v[j].x * v[j].x + v[j].y * v[j].y) + (v[j].z * v[j].z + v[j].w * v[j].w); }
    const float rstd = 1.f / sqrtf(wave_sum(s) * (1.f / D) + RMS_EPS);
    unsigned long long* o8 = (unsigned long long*)orow + lane;
#pragma unroll
    for (int j = 0; j < 4; ++j) { const f32x4 ww = wr[64 * j]; o8[64 * j] = (unsigned long long)pk2(v[j].x * rstd * ww.x, v[j].y * rstd * ww.y) | ((unsigned long long)pk2(v[j].z * rstd * ww.z, v[j].w * rstd * ww.w) << 32); }
}
__device__ __forceinline__ void rms_row_f32(float* xrow, const float* w, int lane) {
    f32x4* xr = (f32x4*)xrow + lane; const f32x4* wr = (const f32x4*)w + lane;
    f32x4 v[4]; float s = 0.f;
#pragma unroll
    for (int j = 0; j < 4; ++j) { v[j] = xr[64 * j]; s += (v[j].x * v[j].x + v[j].y * v[j].y) + (v[j].z * v[j].z + v[j].w * v[j].w); }
    const float rstd = 1.f / sqrtf(wave_sum(s) * (1.f / D) + RMS_EPS);
#pragma unroll
    for (int j = 0; j < 4; ++j) { const f32x4 ww = wr[64 * j]; xr[64 * j] = v[j] * rstd * ww; }
}
__device__ __forceinline__ void diff_row(bf16* o1row, const bf16* o2row, const float* subw, float lam, float post, int lane) {
    v4u a0 = *((const v4u*)o1row + 2 * lane), a1 = *((const v4u*)o1row + 2 * lane + 1);
    v4u b0 = *((const v4u*)o2row + 2 * lane), b1 = *((const v4u*)o2row + 2 * lane + 1);
    float x[16], y[16]; pg8::unpack8(a0, *(float(*)[8])&x[0]); pg8::unpack8(a1, *(float(*)[8])&x[8]); pg8::unpack8(b0, *(float(*)[8])&y[0]); pg8::unpack8(b1, *(float(*)[8])&y[8]);
    float ss = 0.f;
#pragma unroll
    for (int j = 0; j < 16; ++j) { x[j] = x[j] - lam * y[j]; ss += x[j] * x[j]; }
    ss += __shfl_xor(ss, 1); ss += __shfl_xor(ss, 2); ss += __shfl_xor(ss, 4);
    const float rstd = post / sqrtf(ss * (1.f / 128.f) + SUBLN_EPS);
    const f32x4* wp = (const f32x4*)(subw + 16 * (lane & 7));
    float o[16];
#pragma unroll
    for (int q = 0; q < 4; ++q) { const f32x4 ww = wp[q]; o[4 * q] = x[4 * q] * rstd * ww.x; o[4 * q + 1] = x[4 * q + 1] * rstd * ww.y; o[4 * q + 2] = x[4 * q + 2] * rstd * ww.z; o[4 * q + 3] = x[4 * q + 3] * rstd * ww.w; }
    v4u r0, r1; r0.x = pk2(o[0], o[1]); r0.y = pk2(o[2], o[3]); r0.z = pk2(o[4], o[5]); r0.w = pk2(o[6], o[7]); r1.x = pk2(o[8], o[9]); r1.y = pk2(o[10], o[11]); r1.z = pk2(o[12], o[13]); r1.w = pk2(o[14], o[15]);
    *((v4u*)o1row + 2 * lane) = r0; *((v4u*)o1row + 2 * lane + 1) = r1;
}

struct Args { const float* in[12]; float* out; unsigned char* ws; int ph_lo, ph_hi, coop, pad; };

typedef const __attribute__((address_space(4))) Args* ArgsP;
__device__ __forceinline__ ArgsP get_args() { ArgsP p = (ArgsP)__builtin_amdgcn_kernarg_segment_ptr(); asm volatile("" : "+s"(p)); return p; }
#define Sk(k) ((bf16*)(ws + WS_S + (size_t)(k) * SLOT))
#define PHASE_LOCALS \
    ArgsP ap = get_args(); \
    LAS unsigned char* ldsl = (LAS unsigned char*)lds; \
    const int tid = threadIdx.x, lane = tid & 63, wave = __builtin_amdgcn_readfirstlane(tid >> 6); \
    const int G = gridDim.x; const int bx = blockIdx.x; const int vcu = (G % 8 == 0) ? (bx % 8) * (G / 8) + bx / 8 : bx; \
    const int gw = vcu * NWAVES + wave, NGW = G * NWAVES; \
    unsigned char* ws = ap->ws; float* out = ap->out; \
    float* cs = (float*)(ws + WS_CS); bf16* S0 = (bf16*)(ws + WS_S); \
    float* Mst = (float*)(ws + WS_ML); float* Lst = (float*)(ws + WS_ML + MiB); \
    unsigned char* wl = ws + WS_W + (size_t)(layer < DEPTH ? layer : 0) * W_LAYER; \
    bf16* WIN_T = (bf16*)wl; bf16* WA_T = (bf16*)(wl + W_A); bf16* WB_T = (bf16*)(wl + W_B); bf16* WO_T = (bf16*)(wl + W_O); \
    const float* resid = (layer == 0) ? ap->in[0] : out; \
    (void)ldsl; (void)lane; (void)gw; (void)NGW; (void)cs; (void)S0; (void)Mst; (void)Lst; (void)WIN_T; (void)WA_T; (void)WB_T; (void)WO_T; (void)resid; (void)tid; (void)bx;

template <int SUB> __device__ __forceinline__ void run_phase(const int layer) {
    extern __shared__ __attribute__((aligned(16))) unsigned char lds[];
    if constexpr (SUB == 0) {
#if (PHM >> 0) & 1
            PHASE_LOCALS
            if (layer == 0) {
                LAS float* scr = (LAS float*)(ldsl + wave * 16384);
                constexpr int I_IN = (D / 64) * (NIN / 32), I_SQ = (D / 64) * (D / 32), I_L = I_IN + 3 * I_SQ;
                for (int it = gw; it < DEPTH * I_L; it += NGW) {
                    const int l = it / I_L; int r = it % I_L;
                    unsigned char* wd = ws + WS_W + (size_t)l * W_LAYER;
                    if (r < I_IN) { const int nb = r % (NIN / 32), g = nb / 32; const int dg = (g == 3) ? 6 : (g >= 4 && g <= 6) ? g - 1 : g;
                        transpose_item(ap->in[2] + (size_t)l * D * NIN, D, NIN, NIN / 32, (bf16*)wd, (dg - g) * 1024, scr, r, lane); continue; }
                    r -= I_IN;
                    const int which = r / I_SQ; r %= I_SQ;
                    const float* src = (which == 0 ? ap->in[8] : which == 1 ? ap->in[9] : ap->in[10]) + (size_t)l * D * D;
                    bf16* dst = (bf16*)(wd + (which == 0 ? W_A : which == 1 ? W_B : W_O));
                    transpose_item(src, D, D, D / 32, dst, 0, scr, r, lane);
                }
                for (int e = bx * (NWAVES * 64) + tid; e < T * 8; e += G * NWAVES * 64) {
                    const int pos = e >> 3, i = e & 7;
                    const double r0 = 0.15915494309189535, r1 = 0.03086376340470123, r2 = 0.005985185712713705, r3 = 0.001160663641240061, r4 = 0.00022507907903927653, r5 = 4.364795279280289e-05, r6 = 8.464330808241401e-06, r7 = 1.6414262627950345e-06;
                    double rev = (double)pos * (i == 0 ? r0 : i == 1 ? r1 : i == 2 ? r2 : i == 3 ? r3 : i == 4 ? r4 : i == 5 ? r5 : i == 6 ? r6 : r7);
                    rev -= __builtin_rint(rev);
                    const float rf = (float)rev;
                    cs[2 * e] = __builtin_amdgcn_cosf(rf); cs[2 * e + 1] = __builtin_amdgcn_sinf(rf);
                }
            }
            const float* nw = ap->in[1] + (size_t)layer * D;
            for (int m = gw; m < M; m += NGW) rms_row_to_bf16(resid + (size_t)m * D, nw, S0 + (size_t)m * D, lane);
#endif
    }
    if constexpr (SUB == 1) {
#if (PHM >> 1) & 1
            PHASE_LOCALS
            pg8::Gemm g{S0, WIN_T, M, 6144, D}; pg8::StaticOrder S; S.init(M, 6144, G, bx);
            pg8::EpiQKV E{Sk(1), (size_t)SLOT / 2, cs, attn_body::C2};
            pg8::gemm_phase<pg8::EpiQKV, pg8::StaticOrder, PG8_ALIGN, PG8_SP2>(ldsl, g, S, E);
#endif
    }
    if constexpr (SUB >= 2 && SUB <= 4) {
#if (PHM >> 2) & 1
            PHASE_LOCALS
            const int pat = SUB - 2, dil = (pat == 0) ? 1 : (pat == 1) ? 4 : 16;
            attn_body::mixa_phase(pat, dil, vcu, G, (const attn_body::bf16*)Sk(1), (const attn_body::bf16*)Sk(2), (const attn_body::bf16*)Sk(3), (attn_body::bf16*)Sk(7), Mst, Lst, (char*)lds);
#endif
    }
    if constexpr (SUB == 5) {
#if (PHM >> 5) & 1
            PHASE_LOCALS
            for (int L = vcu; L < 2048; L += G) {
                int bh, qb;
                if (G == 256) { const int i = L / 256, s = vcu & 7, j = i & 3; bh = (vcu >> 3) + 32 * (i >> 2); qb = (j == 0) ? s : (j == 1) ? 15 - s : (j == 2) ? 16 + s : 31 - s; }
                else { bh = L >> 5; qb = L & 31; }
                const int b = bh >> 5, vh = bh & 31, h = vh >> 2, mm = (vh >> 1) & 1, e = vh & 1;
                attn_body::attn_unit<8>(b, 0, qb, (const attn_body::bf16*)Sk(4) + (2 * h + mm) * 64, (const attn_body::bf16*)Sk(5) + (2 * h + mm) * 64, (const attn_body::bf16*)Sk(6) + (2 * h + e) * 64,
                                        (attn_body::bf16*)Sk(mm ? 2 : 1) + (2 * h + e) * 64, (char*)lds);
            }
#endif
    }
    if constexpr (SUB == 6) {
#if (PHM >> 6) & 1
            PHASE_LOCALS
            const float li = (layer == 0) ? 0.2f : 0.35550907f;
            const float* lq1 = ap->in[3] + layer * 64; const float* lk1 = ap->in[4] + layer * 64; const float* lq2 = ap->in[5] + layer * 64; const float* lk2 = ap->in[6] + layer * 64;
            const float lam = __expf(wave_sum(lq1[lane] * lk1[lane])) - __expf(wave_sum(lq2[lane] * lk2[lane])) + li;
            const float* sw = ap->in[7] + layer * 128;
            for (int m = gw; m < M; m += NGW) diff_row(Sk(1) + (size_t)m * D, Sk(2) + (size_t)m * D, sw, lam, 1.f - li, lane);
#endif
    }
    if constexpr (SUB == 7) {
#if (PHM >> 7) & 1
            PHASE_LOCALS
            pg8::Gemm g{S0, WIN_T + (size_t)6144 * D, M, 4096, D}; pg8::StaticOrder S; S.init(M, 4096, G, bx);
            pg8::EpiZG E{Sk(3), (size_t)SLOT / 2, Sk(7), Sk(1)};
            pg8::gemm_phase<pg8::EpiZG, pg8::StaticOrder, PG8_ALIGN, PG8_SP2>(ldsl, g, S, E);
#endif
    }
    if constexpr (SUB == 8) {
#if (PHM >> 8) & 1
            PHASE_LOCALS
            pg8::Gemm g{Sk(3), WA_T, M, D, D}; pg8::StaticOrder S; S.init(M, D, G, bx);
            pg8::EpiGateF32 E{(float*)Sk(0), Sk(5)};
            pg8::gemm_phase<pg8::EpiGateF32, pg8::StaticOrder, PG8_ALIGN, PG8_SP2>(ldsl, g, S, E);
#endif
    }
    if constexpr (SUB == 9) {
#if (PHM >> 9) & 1
            PHASE_LOCALS
            pg8::Gemm g{Sk(4), WB_T, M, D, D}; pg8::StaticOrder S; S.init(M, D, G, bx);
            pg8::EpiMerge E{(const float*)Sk(0), Sk(6), Sk(2)};
            pg8::gemm_phase<pg8::EpiMerge, pg8::StaticOrder, PG8_ALIGN, PG8_SP2>(ldsl, g, S, E);
#endif
    }
    if constexpr (SUB == 10) {
#if (PHM >> 10) & 1
            PHASE_LOCALS
            pg8::Gemm g{Sk(2), WO_T, M, D, D}; pg8::StaticOrder S; S.init(M, D, G, bx);
            pg8::EpiResid E{resid, out};
            pg8::gemm_phase<pg8::EpiResid, pg8::StaticOrder, PG8_ALIGN, PG8_SP2>(ldsl, g, S, E);
#endif
    }
    if constexpr (SUB == 100) {
#if (PHM >> 11) & 1
            PHASE_LOCALS
            for (int m = gw; m < M; m += NGW) rms_row_f32(out + (size_t)m * D, ap->in[11], lane);
#endif
    }
}
__global__ void __launch_bounds__(NWAVES * 64, 2) hybrid_fwd(Args args_unused) {
    int ph_lo, ph_hi, coop; { ArgsP ap0 = get_args(); ph_lo = ap0->ph_lo; ph_hi = ap0->ph_hi; coop = ap0->coop; }
    {   extern __shared__ __attribute__((aligned(16))) unsigned char lds[];
        LAS unsigned* lctl = (LAS unsigned*)((LAS unsigned char*)lds + MISC_OFF);
        for (int u = threadIdx.x; u < (LDS_BYTES - MISC_OFF) / 4; u += NWAVES * 64) lctl[u] = 0u;
        __syncthreads();
        if (coop) { ArgsP ap0 = get_args(); (void)xcd_barrier_post((unsigned*)ap0->ws, (volatile LAS unsigned*)((LAS unsigned char*)lds + MISC_OFF) + 8); }
    }
#define GRID_SYNC(first) do { if (coop == 2) cg::this_grid().sync();   else { extern __shared__ __attribute__((aligned(16))) unsigned char lds[]; ArgsP ap1 = get_args(); \
        XcdBarrier xb_; xb_.bar = (unsigned*)ap1->ws; xb_.x = xb_xcc_id(); xb_.st = (volatile LAS unsigned*)((LAS unsigned char*)lds + MISC_OFF) + 8; xcd_barrier(xb_); } } while (0)
#define RUN(L, S) do { const int ph_ = (S == 100) ? N_PHASES - 1 : (L) * PH_PER_LAYER + (S); if (ph_lo <= ph_ && ph_ < ph_hi) { run_phase<S>(L); if (ph_ + 1 < ph_hi && coop) GRID_SYNC(ph_ == 0); } } while (0)
#ifndef PROBE_REP
#define PROBE_REP 0
#endif
#define RUNX(L, S) do { run_phase<S>(L); if (coop) GRID_SYNC(0); } while (0)
#define RUN_LAYER(L) RUN(L, 0); if (PROBE_REP == 3) RUNX(L, 1); RUN(L, 1); if (PROBE_REP == 1) { RUNX(L, 2); RUNX(L, 3); RUNX(L, 4); } RUN(L, 2); RUN(L, 3); RUN(L, 4); if (PROBE_REP == 2) RUNX(L, 5); RUN(L, 5); RUN(L, 6); RUN(L, 7); RUN(L, 8); RUN(L, 9); RUN(L, 10)
#if LAYER_LOOP
#pragma unroll 1
    for (int layer = 0; layer < DEPTH; ++layer) { RUN_LAYER(layer); }
#else
    RUN_LAYER(0); RUN_LAYER(1);
#endif
    RUN(DEPTH, 100);
}

extern "C" void kernel_launch(void* const* d_in, const int* in_sizes, int n_in, void* d_out, int out_size, void* d_ws, size_t ws_size, hipStream_t stream) {
    static int grid = 0;
    if (grid == 0) {
        if (n_in != 12 || in_sizes[0] != M * D || out_size != M * D || ws_size < WS_END) { fprintf(stderr, "kernel_launch: unexpected shapes / workspace (n_in %d, in0 %d, out %d, ws %zu, need %zu)\n", n_in, n_in > 0 ? in_sizes[0] : -1, out_size, ws_size, (size_t)WS_END); grid = -1; return; }
        int dev = 0, cus = 0, per_cu = 0;
        if (hipGetDevice(&dev) != hipSuccess || hipDeviceGetAttribute(&cus, hipDeviceAttributeMultiprocessorCount, dev) != hipSuccess) { grid = -1; return; }
        if (hipFuncSetAttribute((const void*)hybrid_fwd, hipFuncAttributeMaxDynamicSharedMemorySize, LDS_BYTES) != hipSuccess) { fprintf(stderr, "kernel_launch: hipFuncSetAttribute failed\n"); grid = -1; return; }
        if (hipOccupancyMaxActiveBlocksPerMultiprocessor(&per_cu, (const void*)hybrid_fwd, NWAVES * 64, LDS_BYTES) != hipSuccess || per_cu < 1) { fprintf(stderr, "kernel_launch: occupancy query says %d\n", per_cu); per_cu = 1; }
        (void)hipGetLastError();
        grid = cus;
    }
    if (grid < 0) return;
    if (hipMemsetAsync(d_ws, 0, CTL_ZERO_BYTES, stream) != hipSuccess) { fprintf(stderr, "kernel_launch: hipMemsetAsync failed\n"); return; }
    Args a{};
    for (int i = 0; i < 12; ++i) a.in[i] = (const float*)d_in[i];
    a.out = (float*)d_out; a.ws = (unsigned char*)d_ws;
#if MK_COOP
    a.ph_lo = 0; a.ph_hi = N_PHASES; a.coop = 1;
    void* kargs[] = {&a};
    hipError_t e = hipLaunchCooperativeKernel((const void*)hybrid_fwd, dim3(grid), dim3(NWAVES * 64), kargs, LDS_BYTES, stream);
    if (e != hipSuccess) fprintf(stderr, "kernel_launch: cooperative launch failed: %s (grid %d)\n", hipGetErrorString(e), grid);
#else
    for (int ph = 0; ph < N_PHASES; ++ph) {
        a.ph_lo = ph; a.ph_hi = ph + 1; a.coop = 0;
        hipLaunchKernelGGL(hybrid_fwd, dim3(grid), dim3(NWAVES * 64), LDS_BYTES, stream, a);
    }
#endif
}
```

```cpp
#include <hip/hip_runtime.h>
#include <hip/hip_cooperative_groups.h>
#include <cstdio>
#include <cstdint>
namespace cg = cooperative_groups;
namespace pg8 {
#define PG8_LAS __attribute__((address_space(3)))
typedef unsigned short bf16_t;
typedef short bf16x8 __attribute__((ext_vector_type(8)));
typedef float f32x4 __attribute__((ext_vector_type(4)));
typedef unsigned u32x4 __attribute__((ext_vector_type(4)));
constexpr int BM = 256, BK = 64, HALF = 128, HTB = HALF * BK * 2  , STAGE_BYTES = 8 * HTB, NXCD = 8, WGM = 8;

__host__ __device__ __forceinline__ int lds_byte(int r, int c) { const int st = (r >> 4) * 2 + (c >> 5), rr = r & 15, cc = c & 31, ob = rr * 64 + cc * 2; return st * 1024 + (ob ^ (((ob >> 9) & 1) << 5)); }
__host__ __device__ __forceinline__ void stage_rc(int b, int& R, int& C) { const int st = b / 1024, sb = b % 1024, swz = sb ^ (((sb >> 9) & 1) << 5); R = (st >> 1) * 16 + swz / 64; C = (st & 1) * 32 + (swz % 64) / 2; }
__host__ __device__ __forceinline__ int perm32(int rho) { const int n = rho >> 4, i = rho & 15; return 8 * (i >> 2) + 4 * n + (i & 3); }

struct Unit { int pm, pn; };
struct Gemm { const bf16_t* A; const bf16_t* Bt; int M, N, K; };

struct StaticOrder {
    int nM, nN, nwg, G, c;
    __host__ __device__ void init(int M, int N, int G_, int c_) { nM = M / BM; nN = N / BM; nwg = nM * nN; G = G_; c = c_; }
    __host__ __device__ bool next(int i, Unit& u) const {
        const long L = (long)i * G + c; if (L >= nwg) return false;
        int wgid = (int)L; { const int q = nwg / NXCD, r = nwg % NXCD, xcd = wgid % NXCD, off = wgid / NXCD; wgid = (xcd < r ? xcd * (q + 1) : r * (q + 1) + (xcd - r) * q) + off; }
        const int nig = WGM * nN, gid = wgid / nig, fm = gid * WGM, gsz = (nM - fm) < WGM ? (nM - fm) : WGM;
        u.pm = fm + ((wgid % nig) % gsz); u.pn = (wgid % nig) / gsz; return true;
    }
    __device__ __forceinline__ void a_ready(const Unit&) const {}
    __device__ __forceinline__ void done(const Unit&) const {}
};

__device__ __forceinline__ unsigned cvt_pk_bf16(float lo, float hi) { unsigned r; asm volatile("v_cvt_pk_bf16_f32 %0, %1, %2" : "=v"(r) : "v"(lo), "v"(hi)); return r; }
typedef float f32x2 __attribute__((ext_vector_type(2)));
typedef unsigned u32x2 __attribute__((ext_vector_type(2)));
__device__ __forceinline__ float bf_lo(unsigned w) { return __uint_as_float(w << 16); }
__device__ __forceinline__ float bf_hi(unsigned w) { return __uint_as_float(w & 0xffff0000u); }
__device__ __forceinline__ float sigmoid_f(float x) { return __builtin_amdgcn_rcpf(1.0f + __builtin_amdgcn_exp2f(-1.4426950408889634f * x)); }
__device__ __forceinline__ void unpack8(const u32x4 w, float (&f)[8]) { f[0] = bf_lo(w.x); f[1] = bf_hi(w.x); f[2] = bf_lo(w.y); f[3] = bf_hi(w.y); f[4] = bf_lo(w.z); f[5] = bf_hi(w.z); f[6] = bf_lo(w.w); f[7] = bf_hi(w.w); }
__device__ __forceinline__ u32x4 pack8(const float (&f)[8]) { u32x4 w; w.x = cvt_pk_bf16(f[0], f[1]); w.y = cvt_pk_bf16(f[2], f[3]); w.z = cvt_pk_bf16(f[4], f[5]); w.w = cvt_pk_bf16(f[6], f[7]); return w; }

struct EpiQKV {
    static constexpr bool PERM = true, AFTER_DRAIN = false;
    bf16_t* O; size_t gstride; const float* cs; float qscale;
    __device__ __forceinline__ void operator()(const f32x4 (&acc)[2][2][4][2], const Unit& u, int wr, int wc, int fr, int fq) const {
        const int t = u.pn >> 2, colt = (u.pn & 3) * BM;
        bf16_t* base = O + (size_t)t * gstride;
        const bool is_rope = (t != 2) && (t != 5);
        const float sc = (t == 0 || t == 3) ? qscale : 1.f;
        const int row0 = u.pm * BM + wr * 64 + fr, col0 = colt + wc * 32 + 8 * fq;
        const bool ropew = is_rope && ((wc & 1) == 0);
        const bool ropel = fq < 2;
        const float sgn = (fq == 0) ? -1.f : 1.f;
#pragma unroll
        for (int ai = 0; ai < 2; ++ai)
#pragma unroll
            for (int m = 0; m < 4; ++m) {
                const int row = row0 + ai * HALF + m * 16;
                bf16_t* rowp = base + (size_t)row * 1024 + col0;
                f32x4 c01 = {1.f, 0.f, 1.f, 0.f}, c23 = c01, c45 = c01, c67 = c01;
                if (ropew) { const f32x4* cp = (const f32x4*)(cs + (size_t)(row & 8191) * 16); c01 = cp[0]; c23 = cp[1]; c45 = cp[2]; c67 = cp[3]; }
#pragma unroll
                for (int bj = 0; bj < 2; ++bj) {
                    float v[8]; { const f32x4 v0 = acc[ai][bj][m][0], v1 = acc[ai][bj][m][1]; v[0] = v0[0]; v[1] = v0[1]; v[2] = v0[2]; v[3] = v0[3]; v[4] = v1[0]; v[5] = v1[1]; v[6] = v1[2]; v[7] = v1[3]; }
                    if (ropew) {
                        float p[8];
#pragma unroll
                        for (int j = 0; j < 8; ++j) p[j] = __shfl_xor(v[j], 16);
                        if (ropel) {
                            v[0] = v[0] * c01[0] + sgn * p[0] * c01[1]; v[1] = v[1] * c01[2] + sgn * p[1] * c01[3];
                            v[2] = v[2] * c23[0] + sgn * p[2] * c23[1]; v[3] = v[3] * c23[2] + sgn * p[3] * c23[3];
                            v[4] = v[4] * c45[0] + sgn * p[4] * c45[1]; v[5] = v[5] * c45[2] + sgn * p[5] * c45[3];
                            v[6] = v[6] * c67[0] + sgn * p[6] * c67[1]; v[7] = v[7] * c67[2] + sgn * p[7] * c67[3];
                        }
                    }
#pragma unroll
                    for (int j = 0; j < 8; ++j) v[j] *= sc;
                    *(u32x4*)(rowp + bj * HALF) = pack8(v);
                }
            }
    }
};
struct EpiZG {
    static constexpr bool PERM = true, AFTER_DRAIN = false;
    bf16_t* O; size_t gstride; const bf16_t* mul0; const bf16_t* mul1;
    __device__ __forceinline__ void operator()(const f32x4 (&acc)[2][2][4][2], const Unit& u, int wr, int wc, int fr, int fq) const {
        const int t = u.pn >> 2, colt = (u.pn & 3) * BM;
        bf16_t* base = O + (size_t)t * gstride;
        const bf16_t* mul = (t == 0) ? mul0 : mul1;
        const int row0 = u.pm * BM + wr * 64 + fr, col0 = colt + wc * 32 + 8 * fq;
#pragma unroll
        for (int ai = 0; ai < 2; ++ai)
#pragma unroll
            for (int m = 0; m < 4; ++m) {
                const size_t off = (size_t)(row0 + ai * HALF + m * 16) * 1024 + col0;
#pragma unroll
                for (int bj = 0; bj < 2; ++bj) {
                    float v[8]; { const f32x4 v0 = acc[ai][bj][m][0], v1 = acc[ai][bj][m][1]; v[0] = v0[0]; v[1] = v0[1]; v[2] = v0[2]; v[3] = v0[3]; v[4] = v1[0]; v[5] = v1[1]; v[6] = v1[2]; v[7] = v1[3]; }
                    if (t < 2) {
                        float mv[8]; unpack8(*(const u32x4*)(mul + off + bj * HALF), mv);
#pragma unroll
                        for (int j = 0; j < 8; ++j) v[j] = v[j] * sigmoid_f(v[j]) * mv[j];
                    } else {
#pragma unroll
                        for (int j = 0; j < 8; ++j) v[j] = sigmoid_f(v[j]);
                    }
                    *(u32x4*)(base + off + bj * HALF) = pack8(v);
                }
            }
    }
};
struct EpiGateF32 {
    static constexpr bool PERM = true, AFTER_DRAIN = false;
    float* T; const bf16_t* gate;
    __device__ __forceinline__ void operator()(const f32x4 (&acc)[2][2][4][2], const Unit& u, int wr, int wc, int fr, int fq) const {
        const int row0 = u.pm * BM + wr * 64 + fr, col0 = u.pn * BM + wc * 32 + 8 * fq;
#pragma unroll
        for (int ai = 0; ai < 2; ++ai)
#pragma unroll
            for (int m = 0; m < 4; ++m) {
                const size_t off = (size_t)(row0 + ai * HALF + m * 16) * 1024 + col0;
#pragma unroll
                for (int bj = 0; bj < 2; ++bj) {
                    float g[8]; unpack8(*(const u32x4*)(gate + off + bj * HALF), g);
                    const f32x4 v0 = acc[ai][bj][m][0], v1 = acc[ai][bj][m][1];
                    *(f32x4*)(T + off + bj * HALF) = (f32x4){v0[0] * g[0], v0[1] * g[1], v0[2] * g[2], v0[3] * g[3]};
                    *(f32x4*)(T + off + bj * HALF + 4) = (f32x4){v1[0] * g[4], v1[1] * g[5], v1[2] * g[6], v1[3] * g[7]};
                }
            }
    }
};
struct EpiMerge {
    static constexpr bool PERM = true, AFTER_DRAIN = false;
    const float* T; const bf16_t* gate; bf16_t* O;
    __device__ __forceinline__ void operator()(const f32x4 (&acc)[2][2][4][2], const Unit& u, int wr, int wc, int fr, int fq) const {
        const int row0 = u.pm * BM + wr * 64 + fr, col0 = u.pn * BM + wc * 32 + 8 * fq;
#pragma unroll
        for (int ai = 0; ai < 2; ++ai)
#pragma unroll
            for (int m = 0; m < 4; ++m) {
                const size_t off = (size_t)(row0 + ai * HALF + m * 16) * 1024 + col0;
#pragma unroll
                for (int bj = 0; bj < 2; ++bj) {
                    float g[8]; unpack8(*(const u32x4*)(gate + off + bj * HALF), g);
                    const f32x4 t0 = *(const f32x4*)(T + off + bj * HALF), t1 = *(const f32x4*)(T + off + bj * HALF + 4);
                    const f32x4 v0 = acc[ai][bj][m][0], v1 = acc[ai][bj][m][1];
                    float v[8] = {t0[0] + v0[0] * g[0], t0[1] + v0[1] * g[1], t0[2] + v0[2] * g[2], t0[3] + v0[3] * g[3], t1[0] + v1[0] * g[4], t1[1] + v1[1] * g[5], t1[2] + v1[2] * g[6], t1[3] + v1[3] * g[7]};
                    *(u32x4*)(O + off + bj * HALF) = pack8(v);
                }
            }
    }
};
struct EpiPair {
    static constexpr bool PERM = true, AFTER_DRAIN = false;
    EpiGateF32 a; EpiMerge b;
    __device__ __forceinline__ void operator()(const f32x4 (&acc)[2][2][4][2], const Unit& u, int wr, int wc, int fr, int fq) const {
        Unit r; r.pm = u.pm & 63; r.pn = u.pn & 3;
        if (u.pm < 64) a(acc, r, wr, wc, fr, fq); else b(acc, r, wr, wc, fr, fq);
    }
};
struct PairOrder {
    StaticOrder base;
    __host__ __device__ bool next(int i, Unit& u) const { if (i >= 2) return false; Unit t; if (!base.next(0, t)) return false; u.pm = t.pm + 64 * i; u.pn = t.pn + 4 * i; return true; }
    __device__ __forceinline__ void a_ready(const Unit&) const {}
    __device__ __forceinline__ void done(const Unit&) const {}
};
struct EpiResid {
    static constexpr bool PERM = true, AFTER_DRAIN = false;
    const float* res; float* out;
    __device__ __forceinline__ void operator()(const f32x4 (&acc)[2][2][4][2], const Unit& u, int wr, int wc, int fr, int fq) const {
        const int row0 = u.pm * BM + wr * 64 + fr, col0 = u.pn * BM + wc * 32 + 8 * fq;
#pragma unroll
        for (int ai = 0; ai < 2; ++ai)
#pragma unroll
            for (int m = 0; m < 4; ++m) {
                const size_t off = (size_t)(row0 + ai * HALF + m * 16) * 1024 + col0;
#pragma unroll
                for (int bj = 0; bj < 2; ++bj) {
                    const f32x4 r0 = *(const f32x4*)(res + off + bj * HALF), r1 = *(const f32x4*)(res + off + bj * HALF + 4);
                    *(f32x4*)(out + off + bj * HALF) = r0 + acc[ai][bj][m][0];
                    *(f32x4*)(out + off + bj * HALF + 4) = r1 + acc[ai][bj][m][1];
                }
            }
    }
};

template <class Epi, class Sched, bool ALIGN_EPI = false, bool SP2 = false>
__device__ __forceinline__ void gemm_phase(PG8_LAS unsigned char* lds, const Gemm g, const Sched& S, const Epi& E) {
    const int tid = threadIdx.x, wid = __builtin_amdgcn_readfirstlane(tid >> 6), lane = tid & 63, wr = wid >> 2, wc = wid & 3, fr = lane & 15, fq = lane >> 4;
    const int K = g.K, nt = K / BK;
    unsigned voffA[2], voffB[2];
#pragma unroll
    for (int i = 0; i < 2; ++i) { int R, C; stage_rc(tid * 16 + i * 8192, R, C); const int Rb = Epi::PERM ? ((R & ~31) + perm32(R & 31)) : R;
        voffA[i] = (unsigned)(R * K + C) * 2u; voffB[i] = (unsigned)(Rb * K + C) * 2u; }
    const size_t kstep = (size_t)(BK * 2);
    const size_t hstep = (size_t)HALF * K * 2;
    const size_t tstep = 2 * hstep;
    const unsigned ldsw = (unsigned)wid * 1024u;
    const int aoff = lds_byte(wr * 64 + fr, fq * 8), boff = lds_byte(wc * 32 + fr, fq * 8);
#define PG8_SA(b, h) (((b) * 2 + (h)) * HTB)
#define PG8_SB(b, h) ((4 + (b) * 2 + (h)) * HTB)
#define PG8_STAGE(bufoff, gbase, voff) do { _Pragma("unroll") for (int _i = 0; _i < 2; ++_i) \
        __builtin_amdgcn_global_load_lds((const unsigned*)((const char*)(gbase) + (voff)[_i]), (PG8_LAS unsigned*)(lds + (bufoff) + ldsw + _i * 8192), 16, 0, 0); } while (0)
#define PG8_LDA(dst, b, h) do { _Pragma("unroll") for (int m = 0; m < 4; ++m) _Pragma("unroll") for (int k = 0; k < 2; ++k) dst[m][k] = *(const PG8_LAS bf16x8*)(lds + PG8_SA(b, h) + aoff + m * 2048 + k * 1024); } while (0)
#define PG8_LDB(dst, b, h) do { _Pragma("unroll") for (int n = 0; n < 2; ++n) _Pragma("unroll") for (int k = 0; k < 2; ++k) dst[n][k] = *(const PG8_LAS bf16x8*)(lds + PG8_SB(b, h) + boff + n * 2048 + k * 1024); } while (0)
#define PG8_MMA(ai, bj, At, Bt) do { __builtin_amdgcn_s_setprio(1); _Pragma("unroll") for (int m = 0; m < 4; ++m) _Pragma("unroll") for (int n = 0; n < 2; ++n) _Pragma("unroll") for (int k = 0; k < 2; ++k) \
        acc[ai][bj][m][n] = __builtin_amdgcn_mfma_f32_16x16x32_bf16(Bt[n][k], At[m][k], acc[ai][bj][m][n], 0, 0, 0); __builtin_amdgcn_s_setprio(0); } while (0)
#define PG8_WAIT_V(n) asm volatile("s_waitcnt vmcnt(" #n ")" ::: "memory")
#define PG8_WAIT_L(n) asm volatile("s_waitcnt lgkmcnt(" #n ")" ::: "memory")
#define PG8_BAR __builtin_amdgcn_s_barrier()
#define PG8_SCHED __builtin_amdgcn_sched_barrier(0)
    Unit cur, nxt; int ui = 0;
    if (!S.next(0, cur)) return;
    f32x4 acc[2][2][4][2];
#pragma unroll
    for (int a = 0; a < 2; ++a)
#pragma unroll
        for (int b = 0; b < 2; ++b)
#pragma unroll
            for (int m = 0; m < 4; ++m)
#pragma unroll
                for (int n = 0; n < 2; ++n) acc[a][b][m][n] = (f32x4){0.f, 0.f, 0.f, 0.f};
    bf16x8 At[4][2], B0[2][2], B1[2][2];
    const char* cA = (const char*)g.A + (size_t)cur.pm * tstep; const char* cB = (const char*)g.Bt + (size_t)cur.pn * tstep;
    S.a_ready(cur);
    if constexpr (SP2) {
        PG8_STAGE(PG8_SB(0, 0), cB, voffB); PG8_STAGE(PG8_SB(0, 1), cB + hstep, voffB); PG8_STAGE(PG8_SA(0, 0), cA, voffA); PG8_STAGE(PG8_SA(0, 1), cA + hstep, voffA);
        if (wr == 1) PG8_BAR;
        PG8_WAIT_V(2); PG8_BAR;
        PG8_STAGE(PG8_SB(1, 0), cB + kstep, voffB); PG8_STAGE(PG8_SA(1, 0), cA + kstep, voffA); PG8_STAGE(PG8_SB(1, 1), cB + hstep + kstep, voffB);
        PG8_WAIT_V(6); PG8_BAR;
    } else {
        PG8_STAGE(PG8_SB(0, 0), cB, voffB); PG8_STAGE(PG8_SA(0, 0), cA, voffA); PG8_STAGE(PG8_SB(0, 1), cB + hstep, voffB); PG8_STAGE(PG8_SA(0, 1), cA + hstep, voffA);
        if (wr == 1) PG8_BAR;
        PG8_WAIT_V(4); PG8_BAR;
        PG8_STAGE(PG8_SB(1, 0), cB + kstep, voffB); PG8_STAGE(PG8_SA(1, 0), cA + kstep, voffA); PG8_STAGE(PG8_SB(1, 1), cB + hstep + kstep, voffB);
        PG8_WAIT_V(6); PG8_BAR;
    }
    for (;;) {
        const bool has_next = S.next(ui + 1, nxt);
        const char* nA = has_next ? (const char*)g.A + (size_t)nxt.pm * tstep : cA; const char* nB = has_next ? (const char*)g.Bt + (size_t)nxt.pn * tstep : cB;
        for (int t = 0; t < nt; t += 2) {
            const bool last = (t == nt - 2);
            const char* a1 = cA + (size_t)(t + 1) * kstep;
            const char* a2 = last ? nA : cA + (size_t)(t + 2) * kstep; const char* b2 = last ? nB : cB + (size_t)(t + 2) * kstep;
            const char* a3 = a2 + kstep; const char* b3 = b2 + kstep;
            if (last && has_next) S.a_ready(nxt);
            if constexpr (SP2) {
            PG8_LDB(B0, 0, 0); PG8_LDB(B1, 0, 1); PG8_SCHED; PG8_LDA(At, 0, 0); PG8_STAGE(PG8_SA(1, 1), a1 + hstep, voffA);
            PG8_WAIT_V(8); PG8_WAIT_L(0); PG8_BAR; PG8_MMA(0, 0, At, B0); PG8_MMA(0, 1, At, B1); PG8_BAR; PG8_SCHED;
            PG8_LDA(At, 0, 1); PG8_STAGE(PG8_SB(0, 0), b2, voffB); PG8_STAGE(PG8_SB(0, 1), b2 + hstep, voffB); PG8_STAGE(PG8_SA(0, 0), a2, voffA);
            PG8_WAIT_V(8); PG8_WAIT_L(0); PG8_BAR; PG8_MMA(1, 0, At, B0); PG8_MMA(1, 1, At, B1); PG8_BAR; PG8_SCHED;
            PG8_LDB(B0, 1, 0); PG8_LDB(B1, 1, 1); PG8_SCHED; PG8_LDA(At, 1, 0); PG8_STAGE(PG8_SA(0, 1), a2 + hstep, voffA);
            PG8_WAIT_V(8); PG8_WAIT_L(0); PG8_BAR; PG8_MMA(0, 0, At, B0); PG8_MMA(0, 1, At, B1); PG8_BAR; PG8_SCHED;
            PG8_LDA(At, 1, 1); PG8_STAGE(PG8_SB(1, 0), b3, voffB); PG8_STAGE(PG8_SB(1, 1), b3 + hstep, voffB); PG8_STAGE(PG8_SA(1, 0), a3, voffA);
            PG8_WAIT_V(8); PG8_WAIT_L(0); PG8_BAR; PG8_MMA(1, 0, At, B0); PG8_MMA(1, 1, At, B1); PG8_BAR; PG8_SCHED;
            } else {
            PG8_LDB(B0, 0, 0); PG8_SCHED; PG8_LDA(At, 0, 0); PG8_STAGE(PG8_SA(1, 1), a1 + hstep, voffA);
            PG8_WAIT_L(8); PG8_BAR; PG8_WAIT_L(0); PG8_MMA(0, 0, At, B0); PG8_BAR; PG8_SCHED;
            PG8_LDB(B1, 0, 1); PG8_STAGE(PG8_SB(0, 0), b2, voffB);
            PG8_BAR; PG8_WAIT_L(0); PG8_MMA(0, 1, At, B1); PG8_BAR;
            PG8_LDA(At, 0, 1); PG8_STAGE(PG8_SA(0, 0), a2, voffA);
            PG8_BAR; PG8_WAIT_L(0); PG8_MMA(1, 0, At, B0); PG8_BAR; PG8_SCHED;
            PG8_STAGE(PG8_SB(0, 1), b2 + hstep, voffB);
            PG8_WAIT_V(6); PG8_BAR; PG8_MMA(1, 1, At, B1); PG8_BAR;
            PG8_LDB(B0, 1, 0); PG8_SCHED; PG8_LDA(At, 1, 0); PG8_STAGE(PG8_SA(0, 1), a2 + hstep, voffA);
            PG8_WAIT_L(8); PG8_BAR; PG8_WAIT_L(0); PG8_MMA(0, 0, At, B0); PG8_BAR; PG8_SCHED;
            PG8_LDB(B1, 1, 1); PG8_STAGE(PG8_SB(1, 0), b3, voffB);
            PG8_BAR; PG8_WAIT_L(0); PG8_MMA(0, 1, At, B1); PG8_BAR;
            PG8_LDA(At, 1, 1); PG8_STAGE(PG8_SA(1, 0), a3, voffA);
            PG8_BAR; PG8_WAIT_L(0); PG8_MMA(1, 0, At, B0); PG8_BAR; PG8_SCHED;
            PG8_STAGE(PG8_SB(1, 1), b3 + hstep, voffB);
            PG8_WAIT_V(6); PG8_BAR; PG8_MMA(1, 1, At, B1); PG8_BAR;
            }
        }
        if constexpr (ALIGN_EPI) { if (wr == 0) PG8_BAR; }
        if constexpr (!Epi::AFTER_DRAIN) { E(acc, cur, wr, wc, fr, fq); S.done(cur); }
        if (!has_next) break;
#pragma unroll
        for (int a = 0; a < 2; ++a)
#pragma unroll
            for (int b = 0; b < 2; ++b)
#pragma unroll
                for (int m = 0; m < 4; ++m)
#pragma unroll
                    for (int n = 0; n < 2; ++n) acc[a][b][m][n] = (f32x4){0.f, 0.f, 0.f, 0.f};
        cur = nxt; cA = nA; cB = nB; ++ui;
        if constexpr (ALIGN_EPI) { if (wr == 1) PG8_BAR; }
    }
    PG8_WAIT_V(0);
    if constexpr (!ALIGN_EPI) { if (wr == 0) PG8_BAR; }
    PG8_BAR;
    if constexpr (Epi::AFTER_DRAIN) { E.fused(acc, cur, wr, wc, fr, fq, lds, wid, lane); S.done(cur); }
#undef PG8_SA
#undef PG8_SB
#undef PG8_STAGE
#undef PG8_LDA
#undef PG8_LDB
#undef PG8_MMA
#undef PG8_WAIT_V
#undef PG8_WAIT_L
#undef PG8_BAR
#undef PG8_SCHED
}
}

#ifndef PG8_SP2
#define PG8_SP2 true
#endif
#ifndef PG8_ALIGN
#define PG8_ALIGN true
#endif
#include <hip/hip_bf16.h>
#include <cmath>
namespace attn_body {
using bf16=__hip_bfloat16;
using bf16x8=__attribute__((ext_vector_type(8)))short;
using s16x4=__attribute__((ext_vector_type(4)))short;
using f32x16=__attribute__((ext_vector_type(16)))float;
using u32x4=__attribute__((ext_vector_type(4)))unsigned;
constexpr int BATCH=2,NHEAD=16,SEQ=8192,D=64,DM=NHEAD*D;
constexpr int NW=8,QBLK=32,QB=QBLK*NW,KVBLK=64,NQB=SEQ/QB;
constexpr int ATTN_PITCH=DM, ATTN_UNIT_ROWS=QB;
__device__ __forceinline__ int crow(int r,int hi){return (r&3)+8*(r>>2)+4*hi;}
#define SBAR() __builtin_amdgcn_sched_barrier(0)
__device__ __forceinline__ void cmask(f32x16&p0,f32x16&p1,int jb,int qrel,int hi){
  asm volatile("":"+v"(qrel));
  const float NEG=-INFINITY; int kb=64*jb+4*hi; asm volatile("":"+v"(kb));
  #pragma unroll
  for(int r=0;r<16;++r){int kv=kb+(r&3)+8*(r>>2); if(kv>qrel)p0[r]=NEG; if(kv+32>qrel)p1[r]=NEG;}
}

constexpr int NSLOT=3, SLOTB=8192;
constexpr int LDS_K=0, LDS_V=NSLOT*SLOTB, LDS_WS=2*NSLOT*SLOTB, LDS_OST=LDS_WS+NW*64*4, LDS_BYTES=LDS_OST+NW*4096;
constexpr float C2=0.125f*1.4426950408889634f;
__device__ __forceinline__ void glds16(const void*gsrc,unsigned lds_dst){unsigned keep;
  asm volatile("s_mov_b32 %0, m0\n\ts_mov_b32 m0, %2\n\ts_nop 0\n\tglobal_load_lds_dwordx4 %1, off\n\ts_mov_b32 m0, %0":"=&s"(keep):"v"(gsrc),"s"(lds_dst):"memory");}
__device__ __forceinline__ float max3f(float a,float b,float c){float r;asm("v_max3_f32 %0, %1, %2, %3":"=v"(r):"v"(a),"v"(b),"v"(c));return r;}
__device__ __forceinline__ float max2f(float a,float b){float r;asm("v_max_f32_e32 %0, %1, %2":"=v"(r):"v"(a),"v"(b));return r;}
__device__ __forceinline__ float fadd_s(float a,float b){float r;asm("v_add_f32_e32 %0, %1, %2":"=v"(r):"v"(a),"v"(b));return r;}
__device__ __forceinline__ float fsub_s(float a,float b){float r;asm("v_sub_f32_e32 %0, %1, %2":"=v"(r):"v"(a),"v"(b));return r;}
typedef float f32x2_t __attribute__((ext_vector_type(2))); typedef __bf16 bf16x2_t __attribute__((ext_vector_type(2)));
__device__ __forceinline__ unsigned cvtpk_s(float lo,float hi){f32x2_t v={lo,hi};bf16x2_t b=__builtin_convertvector(v,bf16x2_t);return __builtin_bit_cast(unsigned,b);}
#define WAIT_BAR(N) asm volatile("s_waitcnt vmcnt(" #N ") lgkmcnt(0)\n\ts_barrier":::"memory")

__device__ __forceinline__ void qkt(f32x16&p0,f32x16&p1,const char*Kslot,const bf16x8*qr,const f32x16&negm,int r32,int hi){
  const char*kb=Kslot+hi*1024+r32*16;
  #pragma unroll
  for(int d0=0;d0<4;++d0){
    const bf16x8 b0=*reinterpret_cast<const bf16x8*>(kb+d0*2048);
    const bf16x8 b1=*reinterpret_cast<const bf16x8*>(kb+d0*2048+512);
    if(d0==0){p0=__builtin_amdgcn_mfma_f32_32x32x16_bf16(b0,qr[0],negm,0,0,0);p1=__builtin_amdgcn_mfma_f32_32x32x16_bf16(b1,qr[0],negm,0,0,0);}
    else{p0=__builtin_amdgcn_mfma_f32_32x32x16_bf16(b0,qr[d0],p0,0,0,0);p1=__builtin_amdgcn_mfma_f32_32x32x16_bf16(b1,qr[d0],p1,0,0,0);}}
}
typedef __attribute__((address_space(3))) const char* lds_cptr;
typedef short v4i16_t __attribute__((ext_vector_type(4)));
__device__ __forceinline__ void kload8(bf16x8*kf,lds_cptr kp){
  kf[0]=*(const __attribute__((address_space(3))) bf16x8*)(kp);      kf[1]=*(const __attribute__((address_space(3))) bf16x8*)(kp+512);
  kf[2]=*(const __attribute__((address_space(3))) bf16x8*)(kp+2048); kf[3]=*(const __attribute__((address_space(3))) bf16x8*)(kp+2560);
  kf[4]=*(const __attribute__((address_space(3))) bf16x8*)(kp+4096); kf[5]=*(const __attribute__((address_space(3))) bf16x8*)(kp+4608);
  kf[6]=*(const __attribute__((address_space(3))) bf16x8*)(kp+6144); kf[7]=*(const __attribute__((address_space(3))) bf16x8*)(kp+6656);
}
__device__ __forceinline__ void kload2(bf16x8*kf,lds_cptr kp,int j){ kf[2*j]=*(const __attribute__((address_space(3))) bf16x8*)(kp+j*2048); kf[2*j+1]=*(const __attribute__((address_space(3))) bf16x8*)(kp+j*2048+512); }
__device__ __forceinline__ s16x4 vtr(lds_cptr p){ return __builtin_bit_cast(s16x4,__builtin_amdgcn_ds_read_tr16_b64_v4i16((__attribute__((address_space(3))) v4i16_t*)p)); }
__device__ __forceinline__ float rowmax(const f32x16&p0,const f32x16&p1){
  float a=max3f(p0[0],p0[1],p1[0]),b=max3f(p0[2],p0[3],p1[1]);a=max3f(a,p1[2],p1[3]);
  #pragma unroll
  for(int r=4;r<16;r+=4){a=max3f(a,p0[r],p0[r+1]);b=max3f(b,p0[r+2],p0[r+3]);a=max3f(a,p1[r],p1[r+1]);b=max3f(b,p1[r+2],p1[r+3]);}
  const float m=max2f(a,b);
  auto rr=__builtin_amdgcn_permlane32_swap(__float_as_uint(m),__float_as_uint(m),false,false);
  return max2f(__uint_as_float(rr[0]),__uint_as_float(rr[1]));
}
__device__ __forceinline__ void pv(f32x16*o,int vb,bf16x8 pa0,bf16x8 pa1,bf16x8 pa2,bf16x8 pa3){
  #pragma unroll
  for(int d0=0;d0<2;++d0){s16x4 lo[4],hi[4];
    #pragma unroll
    for(int ks=0;ks<4;++ks){
      asm volatile("ds_read_b64_tr_b16 %0,%1 offset:%c2":"=&v"(lo[ks]):"v"(vb),"i"(d0*4096+ks*1024):"memory");
      asm volatile("ds_read_b64_tr_b16 %0,%1 offset:%c2":"=&v"(hi[ks]):"v"(vb),"i"(d0*4096+ks*1024+512):"memory");}
    asm volatile("s_waitcnt lgkmcnt(0)":::"memory");SBAR();
    #define PK(k) (bf16x8){lo[k][0],lo[k][1],lo[k][2],lo[k][3],hi[k][0],hi[k][1],hi[k][2],hi[k][3]}
    o[d0]=__builtin_amdgcn_mfma_f32_32x32x16_bf16(pa0,PK(0),o[d0],0,0,0);
    o[d0]=__builtin_amdgcn_mfma_f32_32x32x16_bf16(pa1,PK(1),o[d0],0,0,0);
    o[d0]=__builtin_amdgcn_mfma_f32_32x32x16_bf16(pa2,PK(2),o[d0],0,0,0);
    o[d0]=__builtin_amdgcn_mfma_f32_32x32x16_bf16(pa3,PK(3),o[d0],0,0,0);
    #undef PK
  }
}

#ifndef ATTN_STORE16
#define ATTN_STORE16(p,v) (*(u32x4*)(p)=(v))
#endif
template<int THRL> __device__ __forceinline__ void attn_unit(int b,int h,int qb,const bf16*Q,const bf16*__restrict__ K,const bf16*__restrict__ V,bf16*O,char*shm){
  const int tid=threadIdx.x,lane=tid&63,r32=lane&31,hi=lane>>5; const int wid=__builtin_amdgcn_readfirstlane(tid>>6);
  const long rowbase=(long)b*SEQ; const int q0=qb*QB;
  const bf16*Qw=Q+(rowbase+q0+wid*QBLK)*DM+h*D;
  const bf16*Kh=K+rowbase*DM+h*D,*Vh=V+rowbase*DM+h*D;
  const unsigned lds0=(unsigned)(uintptr_t)shm;
  float*wsf=(float*)(shm+LDS_WS)+wid*64;
  const bf16*ksrc=Kh+(long)lane*DM+wid*8;
  const bf16*vsrc=Vh+(long)(16*(wid&3)+(lane>>2))*DM+(wid>>2)*32+(lane&3)*8;
  const unsigned kdst=lds0+LDS_K+wid*1024, vdst=lds0+LDS_V+wid*1024;
  #define DMA_K(t,slot) glds16(ksrc+(long)(t)*KVBLK*DM,(unsigned)__builtin_amdgcn_readfirstlane(kdst+(slot)))
  #define DMA_V(t,slot) glds16(vsrc+(long)(t)*KVBLK*DM,(unsigned)__builtin_amdgcn_readfirstlane(vdst+(slot)))
  const int vb0=(int)(lds0+LDS_V)+((lane>>4)&1)*32+(lane&3)*8+(4*hi+((lane&15)>>2))*64;
  const char*Kbase=shm+LDS_K; bf16x8 kf[8];
  const lds_cptr shm3=(lds_cptr)shm; const lds_cptr kp0=shm3+LDS_K+hi*1024+r32*16; const lds_cptr vp0=shm3+LDS_V+((lane>>4)&1)*32+(lane&3)*8+(4*hi+((lane&15)>>2))*64;
  const int NT=(q0+QB)/KVBLK;
  DMA_K(0,0);DMA_V(0,0);DMA_K(1,SLOTB);
  bf16x8 qr[4];
  #pragma unroll
  for(int d0=0;d0<4;++d0)qr[d0]=*reinterpret_cast<const bf16x8*>(&Qw[(long)r32*DM+d0*16+hi*8]);
  float mhat=0.f,l_reg=0.f;f32x16 o[2];o[0]=f32x16{};o[1]=f32x16{};f32x16 negm=f32x16{};asm volatile("":"+v"(negm));
  const int qrel=wid*QBLK+r32;
  #define CMASK(P0,P1,t) do{int jb_=(t)-(NT-4); if(jb_>=0)cmask(P0,P1,jb_,qrel,hi);}while(0)
  bool resc=false;
  #define START(P0,P1) do{ const float rm=rowmax(P0,P1); resc=false; \
    { const float dl=rm; mhat=fadd_s(mhat,dl); \
      _Pragma("unroll") for(int r=0;r<16;++r){P0[r]=fsub_s(P0[r],dl);P1[r]=fsub_s(P1[r],dl);} \
      _Pragma("unroll") for(int r=0;r<16;++r)negm[r]=-mhat; asm volatile("":"+v"(negm)); } \
    _Pragma("unroll") for(int r=0;r<16;++r)P0[r]=__builtin_amdgcn_exp2f(P0[r]); }while(0)
  #define RESC() do{ if(resc){ asm volatile("s_waitcnt lgkmcnt(0)":::"memory"); \
      _Pragma("unroll") for(int d_=0;d_<2;++d_) _Pragma("unroll") for(int r=0;r<16;++r)o[d_][r]*=wsf[crow(r,hi)]; } }while(0)
  f32x16 pA0,pA1,pB0,pB1;
  int sl_prev=0,sl_cur=0,sl_next=SLOTB;
  #define ROT() do{sl_prev=sl_cur;sl_cur=sl_next;sl_next=(sl_next==(NSLOT-1)*SLOTB)?0:sl_next+SLOTB;}while(0)
  DMA_K(2,2*SLOTB);
  WAIT_BAR(3);
  qkt(pA0,pA1,Kbase,qr,negm,r32,hi);asm volatile("s_nop 15\n\ts_nop 7":"+v"(pA0),"+v"(pA1));CMASK(pA0,pA1,0);
  START(pA0,pA1);
  _Pragma("unroll") for(int r=0;r<16;++r)pA1[r]=__builtin_amdgcn_exp2f(pA1[r]);
  WAIT_BAR(0);
  DMA_K(3,0);DMA_V(1,SLOTB);
  ROT();
  kload8(kf,kp0+sl_cur);
  WAIT_BAR(2);
  s16x4 vlo[8],vhi[8]; u32x4 pw0,pw1,pw2,pw3;
  #define PKW(P,B) cvtpk_s(P[B],P[B+1])
  #define PAF(k) __builtin_bit_cast(bf16x8,pw##k)
  #define VFR(i) (bf16x8){vlo[i][0],vlo[i][1],vlo[i][2],vlo[i][3],vhi[i][0],vhi[i][1],vhi[i][2],vhi[i][3]}
  #define PIN(x) asm volatile("":"+v"(x))
  #define MX3(a,b,c) __builtin_fmaxf(__builtin_fmaxf((a),(b)),(c))
  #define GAPA(MF,A0,A1,A2,A3,W0,W1,PW) do{ MF; sacc+=A0; sacc+=A1; sacc+=A2; sacc+=A3; PIN(sacc); W0; W1; PIN(PW); SBAR(); }while(0)
  #define EX(v) __builtin_amdgcn_exp2f(v)
  #define GAPB(MF,X,B) do{ MF; X[B]=EX(X[B]); X[B+1]=EX(X[B+1]); X[B+2]=EX(X[B+2]); X[B+3]=EX(X[B+3]); PIN(X); SBAR(); }while(0)
  #define VRD(i) do{ vlo[i]=vtr(vp_+(((i)>>2)*4096+((i)&3)*1024)); vhi[i]=vtr(vp_+(((i)>>2)*4096+((i)&3)*1024+512)); }while(0)
  #define KRD(G,j) do{ if(G){ kload2(kf,kp0+sl_next,j); SBAR(); } }while(0)
  #define STEP(C0,C1,P0,P1,t,GK,GV,GL) do{ SBAR(); \
    const lds_cptr vp_=vp0+sl_prev; \
    VRD(0); SBAR(); float sacc=(P0[0]+P0[1]); \
    GAPA(C0=__builtin_amdgcn_mfma_f32_32x32x16_bf16(kf[0],qr[0],negm,0,0,0), P0[2],P0[3],P0[4],P0[5],     pw0[0]=PKW(P0,0), pw0[1]=PKW(P0,2), pw0); \
    VRD(4); SBAR(); GAPA(C1=__builtin_amdgcn_mfma_f32_32x32x16_bf16(kf[1],qr[0],negm,0,0,0), P0[6],P0[7],P0[8],P0[9],     pw0[2]=PKW(P0,4), pw0[3]=PKW(P0,6), pw0); \
    VRD(1); SBAR(); GAPA(C0=__builtin_amdgcn_mfma_f32_32x32x16_bf16(kf[2],qr[1],C0,0,0,0),   P0[10],P0[11],P0[12],P0[13], pw1[0]=PKW(P0,8), pw1[1]=PKW(P0,10), pw1); \
    VRD(5); SBAR(); GAPA(C1=__builtin_amdgcn_mfma_f32_32x32x16_bf16(kf[3],qr[1],C1,0,0,0),   P0[14],P0[15],P1[0],P1[1],   pw1[2]=PKW(P0,12),pw1[3]=PKW(P0,14), pw1); \
    VRD(2); SBAR(); GAPA(C0=__builtin_amdgcn_mfma_f32_32x32x16_bf16(kf[4],qr[2],C0,0,0,0),   P1[2],P1[3],P1[4],P1[5],     pw2[0]=PKW(P1,0), pw2[1]=PKW(P1,2), pw2); \
    VRD(6); SBAR(); GAPA(C1=__builtin_amdgcn_mfma_f32_32x32x16_bf16(kf[5],qr[2],C1,0,0,0),   P1[6],P1[7],P1[8],P1[9],     pw2[2]=PKW(P1,4), pw2[3]=PKW(P1,6), pw2); \
    VRD(3); SBAR(); GAPA(C0=__builtin_amdgcn_mfma_f32_32x32x16_bf16(kf[6],qr[3],C0,0,0,0),   P1[10],P1[11],P1[12],P1[13], pw3[0]=PKW(P1,8), pw3[1]=PKW(P1,10), pw3); \
    VRD(7); SBAR(); GAPA(C1=__builtin_amdgcn_mfma_f32_32x32x16_bf16(kf[7],qr[3],C1,0,0,0),   P1[14],P1[15],0.f,0.f,       pw3[2]=PKW(P1,12),pw3[3]=PKW(P1,14), pw3); \
    l_reg+=sacc; \
    if(GK){DMA_K((t)+3,sl_cur);} if(GV){DMA_V((t)+1,sl_next);} \
    CMASK(C0,C1,t); \
    { float a=MX3(C0[0],C0[1],C1[0]),b=MX3(C0[2],C0[3],C1[1]); a=MX3(a,C1[2],C1[3]); \
      _Pragma("unroll") for(int r=4;r<16;r+=4){a=MX3(a,C0[r],C0[r+1]);b=MX3(b,C0[r+2],C0[r+3]);a=MX3(a,C1[r],C1[r+1]);b=MX3(b,C1[r+2],C1[r+3]);} \
      float rm=__builtin_fmaxf(a,b); { auto rr=__builtin_amdgcn_permlane32_swap(__float_as_uint(rm),__float_as_uint(rm),false,false); rm=__builtin_fmaxf(__uint_as_float(rr[0]),__uint_as_float(rr[1])); } \
      resc=false; \
      if(__builtin_expect(__any(rm>(float)THRL),0)){ const float dl=__builtin_fmaxf(rm,0.f); mhat+=dl; \
        _Pragma("unroll") for(int r=0;r<16;++r){C0[r]-=dl;C1[r]-=dl;} \
        _Pragma("unroll") for(int r=0;r<16;++r)negm[r]=-mhat; asm volatile("":"+v"(negm)); \
        const float f=__builtin_amdgcn_exp2f(-dl); l_reg*=f; if(hi==0)wsf[r32]=f; resc=true; } } \
    SBAR(); \
    GAPB(o[0]=__builtin_amdgcn_mfma_f32_32x32x16_bf16(PAF(0),VFR(0),o[0],0,0,0), C0,0); \
    GAPB(o[1]=__builtin_amdgcn_mfma_f32_32x32x16_bf16(PAF(0),VFR(4),o[1],0,0,0), C0,4); \
    KRD(GL,0); GAPB(o[0]=__builtin_amdgcn_mfma_f32_32x32x16_bf16(PAF(1),VFR(1),o[0],0,0,0), C0,8); \
    KRD(GL,1); GAPB(o[1]=__builtin_amdgcn_mfma_f32_32x32x16_bf16(PAF(1),VFR(5),o[1],0,0,0), C0,12); \
    KRD(GL,2); GAPB(o[0]=__builtin_amdgcn_mfma_f32_32x32x16_bf16(PAF(2),VFR(2),o[0],0,0,0), C1,0); \
    KRD(GL,3); GAPB(o[1]=__builtin_amdgcn_mfma_f32_32x32x16_bf16(PAF(2),VFR(6),o[1],0,0,0), C1,4); \
    GAPB(o[0]=__builtin_amdgcn_mfma_f32_32x32x16_bf16(PAF(3),VFR(3),o[0],0,0,0), C1,8); \
    GAPB(o[1]=__builtin_amdgcn_mfma_f32_32x32x16_bf16(PAF(3),VFR(7),o[1],0,0,0), C1,12); \
    }while(0)
  int t=1;
  #undef CMASK
  #define CMASK(P0,P1,t) do{}while(0)
  for(;t+5<NT;t+=2){
    STEP(pB0,pB1,pA0,pA1,t,true,true,true);     WAIT_BAR(2); RESC(); ROT();
    STEP(pA0,pA1,pB0,pB1,t+1,true,true,true);   WAIT_BAR(2); RESC(); ROT();
  }
  #undef CMASK
  #define CMASK(P0,P1,t) do{int jb_=(t)-(NT-4); if(jb_>=0)cmask(P0,P1,jb_,qrel,hi);}while(0)
  #define ENDW(tt) do{ if((tt)+3<NT){WAIT_BAR(2);} else if((tt)+2<NT){WAIT_BAR(1);} else {WAIT_BAR(0);} }while(0)
  for(;t+1<NT;t+=2){
    STEP(pB0,pB1,pA0,pA1,t,(t+3<NT),(t+1<NT),(t+1<NT));       ENDW(t);   RESC(); ROT();
    STEP(pA0,pA1,pB0,pB1,t+1,(t+4<NT),(t+2<NT),(t+2<NT));     ENDW(t+1); RESC(); ROT();
  }
  STEP(pB0,pB1,pA0,pA1,NT-1,false,false,false); RESC();
  { float sacc=pB0[0]+pB0[1]; _Pragma("unroll") for(int r=2;r<16;++r)sacc+=pB0[r]; _Pragma("unroll") for(int r=0;r<16;++r)sacc+=pB1[r]; l_reg+=sacc;
    pw0=(u32x4){PKW(pB0,0),PKW(pB0,2),PKW(pB0,4),PKW(pB0,6)};pw1=(u32x4){PKW(pB0,8),PKW(pB0,10),PKW(pB0,12),PKW(pB0,14)};pw2=(u32x4){PKW(pB1,0),PKW(pB1,2),PKW(pB1,4),PKW(pB1,6)};pw3=(u32x4){PKW(pB1,8),PKW(pB1,10),PKW(pB1,12),PKW(pB1,14)};
    SBAR(); pv(o,vb0+sl_cur,PAF(0),PAF(1),PAF(2),PAF(3)); }
  #undef PKW
  #undef PAF
  #undef VFR
  #undef PIN
  #undef MX3
  #undef GAPA
  #undef GAPB
  #undef EX
  #undef VRD
  #undef KRD
  #undef STEP
  #undef ENDW
  {auto rr=__builtin_amdgcn_permlane32_swap(__float_as_uint(l_reg),__float_as_uint(l_reg),false,false);l_reg=__uint_as_float(rr[0])+__uint_as_float(rr[1]);}
  if(hi==0)wsf[32+r32]=l_reg;asm volatile("s_waitcnt lgkmcnt(0)":::"memory");
  float rli[16];
  #pragma unroll
  for(int r=0;r<16;++r)rli[r]=__builtin_amdgcn_rcpf(wsf[32+crow(r,hi)]);
  bf16*Ow=O+(rowbase+q0+wid*QBLK)*DM+h*D;
  { bf16*stg=(bf16*)(shm+LDS_OST)+wid*2048;
    #pragma unroll
    for(int r=0;r<16;++r){const int orow=crow(r,hi);
      #pragma unroll
      for(int d0=0;d0<2;++d0)stg[orow*64+d0*32+r32]=__float2bfloat16(o[d0][r]*rli[r]);}
    asm volatile("s_waitcnt lgkmcnt(0)":::"memory");
    #pragma unroll
    for(int i=0;i<4;++i){const int row=i*8+(lane>>3),ch=lane&7; const u32x4 v=*(const u32x4*)(stg+row*64+ch*8); ATTN_STORE16(Ow+(long)row*DM+ch*8,v);} }
  asm volatile("s_waitcnt lgkmcnt(0)\n\ts_barrier":::"memory");
  #undef DMA_K
  #undef DMA_V
  #undef CMASK
  #undef START
  #undef RESC
  #undef ROT
}
constexpr int ATTN_LDS_BYTES=LDS_BYTES;
typedef __attribute__((address_space(3))) char* lds_ptr;
constexpr int MIXA_K=0, MIXA_V=49152, MIXA_WS=98304, MIXA_ST=100352, MIXA_LDS_BYTES=MIXA_ST+NW*4096;
#define LDSP(T) __attribute__((address_space(3))) T*
__device__ __forceinline__ void mixa_issue(u32x4(&kr)[6],u32x4(&vr)[6],bf16x8(&qn)[4],int uu,int dil,const bf16*Q,const bf16*K,const bf16*V,int wid,int lane){
  const int bh=uu>>5,q=uu&31,b=bh>>4,h=bh&15,res=q%dil,blk=q/dil; const long pitch=(long)dil*DM; const long tok0=(long)b*SEQ+res; const int i0=blk*256;
  const long roff=(long)(i0-128+wid*8+(lane&7))*pitch+(lane>>3)*8;
  const bf16*kp=K+tok0*DM+h*D+roff; const bf16*vp=V+tok0*DM+h*D+roff;
  #pragma unroll
  for(int jt=0;jt<6;++jt){ if(jt>=2||blk!=0){ kr[jt]=*(const u32x4*)(kp+(long)(64*jt)*pitch); vr[jt]=*(const u32x4*)(vp+(long)(64*jt)*pitch); } }
  const bf16*Qb=Q+tok0*DM+h*D; const int qlo=i0+wid*32,r32=lane&31,hi=lane>>5;
  #pragma unroll
  for(int d0=0;d0<4;++d0)qn[d0]=*reinterpret_cast<const bf16x8*>(&Qb[(long)(qlo+r32)*pitch+d0*16+hi*8]);
}
__device__ __forceinline__ void mixa_phase(int pat,int dil,int vcu,int G,const bf16*Q,const bf16*K,const bf16*V,bf16*Ost,float*Mst,float*Lst,char*shm){
  const int tid=threadIdx.x,lane=tid&63,r32=lane&31,hi=lane>>5; const int wid=__builtin_amdgcn_readfirstlane(tid>>6);
  const long pitch=(long)dil*DM;
  const unsigned lds0=(unsigned)(uintptr_t)shm; const lds_ptr L=(lds_ptr)shm;
  LDSP(float) wsf=(LDSP(float))(L+MIXA_WS)+wid*64;
  LDSP(unsigned short) stg=(LDSP(unsigned short))(L+MIXA_ST)+wid*2048;
  const int vb0=(int)(lds0+MIXA_V)+((lane>>4)&1)*32+(lane&3)*8+(4*hi+((lane&15)>>2))*64;
  u32x4 kr[6],vr[6]; bf16x8 qn[4];
  const int kdst=(lane>>3)*1024+(wid*8+(lane&7))*16;
  const int vdst=((lane>>3)>>2)*4096+(wid>>1)*1024+((wid&1)*8+(lane&7))*64+((lane>>3)&3)*16;
  int uu=vcu*4;
  if(uu<1024)mixa_issue(kr,vr,qn,uu,dil,Q,K,V,wid,lane);
  while(uu<1024){
    const int bh=uu>>5,q=uu&31,b=bh>>4,h=bh&15,res=q%dil,blk=q/dil; const long tok0=(long)b*SEQ+res; const int i0=blk*256,qlo=i0+wid*32,jt0=(blk==0)?2:0;
    bf16*Ob=Ost+tok0*DM+h*D;
    __syncthreads();
    #pragma unroll
    for(int jt=0;jt<6;++jt){ if(jt>=jt0){ *(LDSP(u32x4))(L+MIXA_K+jt*8192+kdst)=kr[jt]; *(LDSP(u32x4))(L+MIXA_V+jt*8192+vdst)=vr[jt]; } }
    __syncthreads();
    bf16x8 qr[4];
    #pragma unroll
    for(int d0=0;d0<4;++d0)qr[d0]=qn[d0];
    const int un=((uu&3)==3)?uu+G*4-3:uu+1;
    if(un<1024)mixa_issue(kr,vr,qn,un,dil,Q,K,V,wid,lane);
    float m_run,l_reg; f32x16 o[2];
    const long grow=tok0+(long)dil*(qlo+r32);
    if(pat==0){ m_run=0.f; l_reg=0.f; o[0]=f32x16{}; o[1]=f32x16{}; }
    else{
      m_run=Mst[grow*16+h]; const float lf=Lst[grow*16+h]; l_reg=(hi==0)?lf:0.f;
      #pragma unroll
      for(int i=0;i<4;++i){const int row=i*8+(lane>>3),ch=lane&7; const u32x4 v=*(const u32x4*)(Ob+(long)(qlo+row)*pitch+ch*8); *(LDSP(u32x4))(stg+row*64+ch*8)=v;}
      if(hi==0)wsf[32+r32]=lf;
      asm volatile("s_waitcnt lgkmcnt(0)":::"memory");
      #pragma unroll
      for(int r=0;r<16;++r){const int orow=crow(r,hi); const float lr=wsf[32+orow];
        #pragma unroll
        for(int d0=0;d0<2;++d0)o[d0][r]=__uint_as_float(((unsigned)stg[orow*64+d0*32+r32])<<16)*lr;}
      asm volatile("s_waitcnt lgkmcnt(0)":::"memory");
    }
    const int qi=qlo+r32;
    #pragma unroll
    for(int c=0;c<3;++c){
      const int jt=(wid>>1)+c;
      if(jt>=jt0){
      const int j0=i0-128+64*jt;
      f32x16 p0,p1; const f32x16 zero=f32x16{};
      qkt(p0,p1,(const char*)shm+MIXA_K+jt*8192,qr,zero,r32,hi);
      #pragma unroll
      for(int r=0;r<16;++r){p0[r]-=m_run;p1[r]-=m_run;}
      if(c==0){ int lim=qi-128-j0-4*hi; asm volatile("":"+v"(lim));
        #pragma unroll
        for(int r=0;r<16;++r){ if((r&3)+8*(r>>2)<lim)p0[r]=-1e30f; if((r&3)+8*(r>>2)+32<lim)p1[r]=-1e30f; } }
      if(c==2){ int lim=qi-j0-4*hi; asm volatile("":"+v"(lim));
        #pragma unroll
        for(int r=0;r<16;++r){ if((r&3)+8*(r>>2)>lim)p0[r]=-1e30f; if((r&3)+8*(r>>2)+32>lim)p1[r]=-1e30f; } }
      float rm=__builtin_fmaxf(__builtin_fmaxf(p0[0],p0[1]),p0[2]);
      #pragma unroll
      for(int r=3;r<15;r+=2)rm=__builtin_fmaxf(__builtin_fmaxf(rm,p0[r]),p0[r+1]);
      rm=__builtin_fmaxf(__builtin_fmaxf(rm,p0[15]),p1[0]);
      #pragma unroll
      for(int r=1;r<15;r+=2)rm=__builtin_fmaxf(__builtin_fmaxf(rm,p1[r]),p1[r+1]);
      rm=__builtin_fmaxf(rm,p1[15]);
      { auto rr=__builtin_amdgcn_permlane32_swap(__float_as_uint(rm),__float_as_uint(rm),false,false); rm=__builtin_fmaxf(__uint_as_float(rr[0]),__uint_as_float(rr[1])); }
      if(__any(rm>8.f)){
        const float dl=__builtin_fmaxf(rm,0.f); const float alpha=__builtin_amdgcn_exp2f(-dl); m_run+=dl;
        l_reg*=alpha;
        #pragma unroll
        for(int r=0;r<16;++r){p0[r]-=dl;p1[r]-=dl;}
        if(hi==0)wsf[r32]=alpha;
        asm volatile("s_waitcnt lgkmcnt(0)":::"memory");
        #pragma unroll
        for(int r=0;r<16;++r){const float a=wsf[crow(r,hi)]; o[0][r]*=a; o[1][r]*=a;}
        asm volatile("s_waitcnt lgkmcnt(0)":::"memory");
      }
      float sacc=0.f;
      #pragma unroll
      for(int r=0;r<16;++r){p0[r]=__builtin_amdgcn_exp2f(p0[r]);p1[r]=__builtin_amdgcn_exp2f(p1[r]);sacc+=p0[r]+p1[r];}
      l_reg+=sacc;
      u32x4 pw0,pw1,pw2,pw3;
      pw0=(u32x4){cvtpk_s(p0[0],p0[1]),cvtpk_s(p0[2],p0[3]),cvtpk_s(p0[4],p0[5]),cvtpk_s(p0[6],p0[7])};
      pw1=(u32x4){cvtpk_s(p0[8],p0[9]),cvtpk_s(p0[10],p0[11]),cvtpk_s(p0[12],p0[13]),cvtpk_s(p0[14],p0[15])};
      pw2=(u32x4){cvtpk_s(p1[0],p1[1]),cvtpk_s(p1[2],p1[3]),cvtpk_s(p1[4],p1[5]),cvtpk_s(p1[6],p1[7])};
      pw3=(u32x4){cvtpk_s(p1[8],p1[9]),cvtpk_s(p1[10],p1[11]),cvtpk_s(p1[12],p1[13]),cvtpk_s(p1[14],p1[15])};
      pv(o,vb0+jt*8192,__builtin_bit_cast(bf16x8,pw0),__builtin_bit_cast(bf16x8,pw1),__builtin_bit_cast(bf16x8,pw2),__builtin_bit_cast(bf16x8,pw3));
      }
    }
    {auto rr=__builtin_amdgcn_permlane32_swap(__float_as_uint(l_reg),__float_as_uint(l_reg),false,false);l_reg=__uint_as_float(rr[0])+__uint_as_float(rr[1]);}
    if(hi==0){ Mst[grow*16+h]=m_run; Lst[grow*16+h]=l_reg; wsf[32+r32]=l_reg; }
    asm volatile("s_waitcnt lgkmcnt(0)":::"memory");
    #pragma unroll
    for(int r=0;r<16;++r){const int orow=crow(r,hi); const float rl=__builtin_amdgcn_rcpf(wsf[32+orow]);
      #pragma unroll
      for(int d0=0;d0<2;++d0){ const __hip_bfloat16 hb=__float2bfloat16(o[d0][r]*rl); stg[orow*64+d0*32+r32]=__builtin_bit_cast(unsigned short,hb); } }
    asm volatile("s_waitcnt lgkmcnt(0)":::"memory");
    #pragma unroll
    for(int i=0;i<4;++i){const int row=i*8+(lane>>3),ch=lane&7; const u32x4 v=*(const LDSP(u32x4))(stg+row*64+ch*8); *(u32x4*)(Ob+(long)(qlo+row)*pitch+ch*8)=v;}
    asm volatile("s_waitcnt lgkmcnt(0)":::"memory");
    uu=un;
  }
  __syncthreads();
}
#undef LDSP
#undef SBAR
#undef WAIT_BAR
}
constexpr int NWAVES = 8;
#ifndef PHM
#define PHM 0xfff
#endif
#ifndef MK_COOP
#define MK_COOP 1
#endif
#ifndef LAYER_LOOP
#define LAYER_LOOP 0
#endif
constexpr int BATCH = 2, T = 8192, D = 1024, M = BATCH * T, DEPTH = 2, NIN = 10240;
constexpr float RMS_EPS = 1e-6f, SUBLN_EPS = 1e-5f;
constexpr int PH_PER_LAYER = 11, N_PHASES = DEPTH * PH_PER_LAYER + 1;

constexpr size_t MiB = 1u << 20;
constexpr size_t WS_CS = 1 * MiB;
constexpr size_t WS_W = 2 * MiB, W_LAYER = 26 * MiB;
constexpr size_t W_A = 20 * MiB, W_B = 22 * MiB, W_O = 24 * MiB;
constexpr size_t WS_S = 54 * MiB, SLOT = 32 * MiB;
constexpr size_t WS_ML = WS_S + 8 * SLOT;
constexpr size_t WS_END = WS_ML + 2 * MiB;
constexpr int LDS_BYTES = 147456;

#define GAS __attribute__((address_space(1)))
#define LAS __attribute__((address_space(3)))
typedef unsigned short bf16;
typedef unsigned v4u __attribute__((ext_vector_type(4)));
typedef float f32x4 __attribute__((ext_vector_type(4)));
#define LDS_WAIT() asm volatile("s_waitcnt lgkmcnt(0)" ::: "memory")
__device__ __forceinline__ unsigned f2bf(float f) { unsigned u = __builtin_bit_cast(unsigned, f); return (u + 0x7fffu + ((u >> 16) & 1u)) >> 16; }
__device__ __forceinline__ unsigned pk2(float lo, float hi) { return f2bf(lo) | (f2bf(hi) << 16); }
__device__ __forceinline__ float wave_sum(float v) {
#pragma unroll
    for (int o = 1; o < 64; o <<= 1) v += __shfl_xor(v, o);
    return v;
}
typedef GAS unsigned gu32;
typedef GAS unsigned long long gu64;
#define RLX_AGENT __ATOMIC_RELAXED, __HIP_MEMORY_SCOPE_AGENT
#define VM_WAIT() asm volatile("s_waitcnt vmcnt(0)" ::: "memory")
#define XB_TMO      128
#define XB_XCNT(j)  (256  + 64 * (j))
#define XB_XSUB(j)  (1280 + 64 * (j))
#define XB_XGEN(j)  (2304 + 64 * (j))
#define XB_TOP      3328
#define XB_TOPGEN   3392
#define XCD_BAR_WORDS 3456
#define XB_SPIN_CAP (1u << 18)

__device__ __forceinline__ unsigned xb_ld(unsigned* p)              { return __hip_atomic_load(p, __ATOMIC_RELAXED, __HIP_MEMORY_SCOPE_AGENT); }
__device__ __forceinline__ unsigned xb_add(unsigned* p, unsigned v) { return __hip_atomic_fetch_add(p, v, __ATOMIC_RELAXED, __HIP_MEMORY_SCOPE_AGENT); }
__device__ __forceinline__ unsigned xb_xcc_id() { return (unsigned)__builtin_amdgcn_s_getreg((3 << 11) | 20) & 0xFu; }
#define XB_SPIN(cond, bar) do { unsigned _sp = 0; while (cond) { __builtin_amdgcn_s_sleep(1); \
    if ((++_sp & 255u) == 0u) { if (xb_ld(&(bar)[XB_TMO])) break; if (_sp > XB_SPIN_CAP) { atomicAdd(&(bar)[XB_TMO], 1u); break; } } } } while (0)

struct XcdBarrier {
    unsigned* bar; unsigned x;
    volatile LAS unsigned* st;
};

__device__ __forceinline__ XcdBarrier xcd_barrier_post(unsigned* bar, volatile LAS unsigned* st) {
    XcdBarrier b; b.bar = bar; b.x = xb_xcc_id(); b.st = st;
    if (threadIdx.x == 0) (void)xb_add(&bar[XB_XCNT(b.x)], 1u);
    return b;
}
__device__ __forceinline__ void xcd_barrier_complete(unsigned* bar, unsigned x, unsigned& nloc, unsigned& nx) {
    const unsigned G = gridDim.x * gridDim.y * gridDim.z;
    unsigned sum, cnt, mine, sp = 0u;
    for (;;) {
        sum = 0u; cnt = 0u; mine = 0u;
#pragma unroll
        for (unsigned j = 0; j < 16; ++j) { const unsigned c = xb_ld(&bar[XB_XCNT(j)]); sum += c; cnt += (c > 0u) ? 1u : 0u; mine = (j == x) ? c : mine; }
        if (sum == G) break;
        __builtin_amdgcn_s_sleep(1);
        if ((++sp & 255u) == 0u) { if (xb_ld(&bar[XB_TMO])) break; if (sp > XB_SPIN_CAP) { atomicAdd(&bar[XB_TMO], 1u); break; } }
    }
    nloc = mine > 0u ? mine : 1u; nx = cnt > 0u ? cnt : 1u;
}

__device__ __forceinline__ void xcd_barrier(const XcdBarrier& b) {
    asm volatile("s_waitcnt vmcnt(0)" ::: "memory");
    __syncthreads();
    if (threadIdx.x == 0) {
        unsigned* bar = b.bar;
        __builtin_amdgcn_s_waitcnt(0);
        unsigned nloc = b.st[0], nx = b.st[1];
        if (nloc == 0u) { xcd_barrier_complete(bar, b.x, nloc, nx); b.st[0] = nloc; b.st[1] = nx; }
        const unsigned old = xb_add(&bar[XB_XSUB(b.x)], 1u);
        const unsigned gen = old / nloc;
        if (old + 1u == (gen + 1u) * nloc) {
            __builtin_amdgcn_fence(__ATOMIC_RELEASE, "agent");
            asm volatile("s_waitcnt vmcnt(0)" ::: "memory");
            const unsigned og = xb_add(&bar[XB_TOP], 1u);
            const unsigned tg = og / nx;
            if (og + 1u == (tg + 1u) * nx) xb_add(&bar[XB_TOPGEN], 1u);
            else XB_SPIN(xb_ld(&bar[XB_TOPGEN]) == tg, bar);
            __builtin_amdgcn_fence(__ATOMIC_ACQUIRE, "agent");
            xb_add(&bar[XB_XGEN(b.x)], 1u);
            asm volatile("s_waitcnt vmcnt(0)" ::: "memory");
        } else {
            XB_SPIN(xb_ld(&bar[XB_XGEN(b.x)]) == gen, bar);
            __builtin_amdgcn_fence(__ATOMIC_ACQUIRE, "agent");
            asm volatile("s_waitcnt vmcnt(0)" ::: "memory");
        }
    }
    __syncthreads();
}

constexpr int MISC_OFF = LDS_BYTES - 256;
constexpr size_t CTL_ZERO_BYTES = 65536;
__device__ __forceinline__ void transpose_item(const float* W, int K, int ldw, int nblk, bf16* WT, int row_off, LAS float* scr, int item, int lane) {
    const int kb = item / nblk, nb = item % nblk, k0 = 64 * kb, n0 = 32 * nb;
#pragma unroll 8
    for (int i = 0; i < 32; ++i) { const int kk = 2 * i + (lane >> 5); scr[kk * 33 + (lane & 31)] = W[(size_t)(k0 + kk) * ldw + n0 + (lane & 31)]; }
    LDS_WAIT(); asm volatile("" ::: "memory");
    const int c = lane & 7;
#pragma unroll
    for (int j = 0; j < 4; ++j) { const int n = (lane >> 3) + 8 * j; const LAS float* s = scr + (8 * c) * 33 + n;
        v4u o; o.x = pk2(s[0 * 33], s[1 * 33]); o.y = pk2(s[2 * 33], s[3 * 33]); o.z = pk2(s[4 * 33], s[5 * 33]); o.w = pk2(s[6 * 33], s[7 * 33]);
        *(v4u*)(WT + (size_t)(row_off + n0 + n) * K + k0 + 8 * c) = o; }
    LDS_WAIT(); asm volatile("" ::: "memory");
}
__device__ __forceinline__ void rms_row_to_bf16(const float* xrow, const float* w, bf16* orow, int lane) {
    const f32x4* xr = (const f32x4*)xrow + lane; const f32x4* wr = (const f32x4*)w + lane;
    f32x4 v[4]; float s = 0.f;
#pragma unroll
    for (int j = 0; j < 4; ++j) { v[j] = xr[64 * j]; s += (v[j].x * v[j].x + v[j].y * v[j].y) + (v[j].z * v[j].z + v[j].w * v[j].w); }
    const float rstd = 1.f / sqrtf(wave_sum(s) * (1.f / D) + RMS_EPS);
    unsigned long long* o8 = (unsigned long long*)orow + lane;
#pragma unroll
    for (int j = 0; j < 4; ++j) { const f32x4 ww = wr[64 * j]; o8[64 * j] = (unsigned long long)pk2(v[j].x * rstd * ww.x, v[j].y * rstd * ww.y) | ((unsigned long long)pk2(v[j].z * rstd * ww.z, v[j].w * rstd * ww.w) << 32); }
}
__device__ __forceinline__ void rms_row_f32(float* xrow, const float* w, int lane) {
    f32x4* xr = (f32x4*)xrow + lane; const f32x4* wr = (const f32x4*)w + lane;
    f32x4 v[4]; float s = 0.f;
#pragma unroll
    for (int j = 0; j < 4; ++j) { v[j] = xr[64 * j]; s += (v[j].x * v[j].x + v[j].y * v[j].y) + (v[j].z * v[j].z + v[j].w * v[j].w); }
    const float rstd = 1.f / sqrtf(wave_sum(s) * (1.f / D) + RMS_EPS);
#pragma unroll
    for (int j = 0; j < 4; ++j) { const f32x4 ww = wr[64 * j]; xr[64 * j] = v[j] * rstd * ww; }
}
__device__ __forceinline__ void diff_row(bf16* o1row, const bf16* o2row, const float* subw, float lam, float post, int lane) {
    v4u a0 = *((const v4u*)o1row + 2 * lane), a1 = *((const v4u*)o1row + 2 * lane + 1);
    v4u b0 = *((const v4u*)o2row + 2 * lane), b1 = *((const v4u*)o2row + 2 * lane + 1);
    float x[16], y[16]; pg8::unpack8(a0, *(float(*)[8])&x[0]); pg8::unpack8(a1, *(float(*)[8])&x[8]); pg8::unpack8(b0, *(float(*)[8])&y[0]); pg8::unpack8(b1, *(float(*)[8])&y[8]);
    float ss = 0.f;
#pragma unroll
    for (int j = 0; j < 16; ++j) { x[j] = x[j] - lam * y[j]; ss += x[j] * x[j]; }
    ss += __shfl_xor(ss, 1); ss += __shfl_xor(ss, 2); ss += __shfl_xor(ss, 4);
    const float rstd = post / sqrtf(ss * (1.f / 128.f) + SUBLN_EPS);
    const f32x4* wp = (const f32x4*)(subw + 16 * (lane & 7));
    float o[16];
#pragma unroll
    for (int q = 0; q < 4; ++q) { const f32x4 ww = wp[q]; o[4 * q] = x[4 * q] * rstd * ww.x; o[4 * q + 1] = x[4 * q + 1] * rstd * ww.y; o[4 * q + 2] = x[4 * q + 2] * rstd * ww.z; o[4 * q + 3] = x[4 * q + 3] * rstd * ww.w; }
    v4u r0, r1; r0.x = pk2(o[0], o[1]); r0.y = pk2(o[2], o[3]); r0.z = pk2(o[4], o[5]); r0.w = pk2(o[6], o[7]); r1.x = pk2(o[8], o[9]); r1.y = pk2(o[10], o[11]); r1.z = pk2(o[12], o[13]); r1.w = pk2(o[14], o[15]);
    *((v4u*)o1row + 2 * lane) = r0; *((v4u*)o1row + 2 * lane + 1) = r1;
}

struct Args { const float* in[12]; float* out; unsigned char* ws; int ph_lo, ph_hi, coop, pad; };

typedef const __attribute__((address_space(4))) Args* ArgsP;
__device__ __forceinline__ ArgsP get_args() { ArgsP p = (ArgsP)__builtin_amdgcn_kernarg_segment_ptr(); asm volatile("" : "+s"(p)); return p; }
#define Sk(k) ((bf16*)(ws + WS_S + (size_t)(k) * SLOT))
#define PHASE_LOCALS \
    ArgsP ap = get_args(); \
    LAS unsigned char* ldsl = (LAS unsigned char*)lds; \
    const int tid = threadIdx.x, lane = tid & 63, wave = __builtin_amdgcn_readfirstlane(tid >> 6); \
    const int G = gridDim.x; const int bx = blockIdx.x; const int vcu = (G % 8 == 0) ? (bx % 8) * (G / 8) + bx / 8 : bx; \
    const int gw = vcu * NWAVES + wave, NGW = G * NWAVES; \
    unsigned char* ws = ap->ws; float* out = ap->out; \
    float* cs = (float*)(ws + WS_CS); bf16* S0 = (bf16*)(ws + WS_S); \
    float* Mst = (float*)(ws + WS_ML); float* Lst = (float*)(ws + WS_ML + MiB); \
    unsigned char* wl = ws + WS_W + (size_t)(layer < DEPTH ? layer : 0) * W_LAYER; \
    bf16* WIN_T = (bf16*)wl; bf16* WA_T = (bf16*)(wl + W_A); bf16* WB_T = (bf16*)(wl + W_B); bf16* WO_T = (bf16*)(wl + W_O); \
    const float* resid = (layer == 0) ? ap->in[0] : out; \
    (void)ldsl; (void)lane; (void)gw; (void)NGW; (void)cs; (void)S0; (void)Mst; (void)Lst; (void)WIN_T; (void)WA_T; (void)WB_T; (void)WO_T; (void)resid; (void)tid; (void)bx;

template <int SUB> __device__ __forceinline__ void run_phase(const int layer) {
    extern __shared__ __attribute__((aligned(16))) unsigned char lds[];
    if constexpr (SUB == 0) {
#if (PHM >> 0) & 1
            PHASE_LOCALS
            if (layer == 0) {
                LAS float* scr = (LAS float*)(ldsl + wave * 16384);
                constexpr int I_IN = (D / 64) * (NIN / 32), I_SQ = (D / 64) * (D / 32), I_L = I_IN + 3 * I_SQ;
                for (int it = gw; it < DEPTH * I_L; it += NGW) {
                    const int l = it / I_L; int r = it % I_L;
                    unsigned char* wd = ws + WS_W + (size_t)l * W_LAYER;
                    if (r < I_IN) { const int nb = r % (NIN / 32), g = nb / 32; const int dg = (g == 3) ? 6 : (g >= 4 && g <= 6) ? g - 1 : g;
                        transpose_item(ap->in[2] + (size_t)l * D * NIN, D, NIN, NIN / 32, (bf16*)wd, (dg - g) * 1024, scr, r, lane); continue; }
                    r -= I_IN;
                    const int which = r / I_SQ; r %= I_SQ;
                    const float* src = (which == 0 ? ap->in[8] : which == 1 ? ap->in[9] : ap->in[10]) + (size_t)l * D * D;
                    bf16* dst = (bf16*)(wd + (which == 0 ? W_A : which == 1 ? W_B : W_O));
                    transpose_item(src, D, D, D / 32, dst, 0, scr, r, lane);
                }
                for (int e = bx * (NWAVES * 64) + tid; e < T * 8; e += G * NWAVES * 64) {
                    const int pos = e >> 3, i = e & 7;
                    const double r0 = 0.15915494309189535, r1 = 0.03086376340470123, r2 = 0.005985185712713705, r3 = 0.001160663641240061, r4 = 0.00022507907903927653, r5 = 4.364795279280289e-05, r6 = 8.464330808241401e-06, r7 = 1.6414262627950345e-06;
                    double rev = (double)pos * (i == 0 ? r0 : i == 1 ? r1 : i == 2 ? r2 : i == 3 ? r3 : i == 4 ? r4 : i == 5 ? r5 : i == 6 ? r6 : r7);
                    rev -= __builtin_rint(rev);
                    const float rf = (float)rev;
                    cs[2 * e] = __builtin_amdgcn_cosf(rf); cs[2 * e + 1] = __builtin_amdgcn_sinf(rf);
                }
            }
            const float* nw = ap->in[1] + (size_t)layer * D;
            for (int m = gw; m < M; m += NGW) rms_row_to_bf16(resid + (size_t)m * D, nw, S0 + (size_t)m * D, lane);
#endif
    }
    if constexpr (SUB == 1) {
#if (PHM >> 1) & 1
            PHASE_LOCALS
            pg8::Gemm g{S0, WIN_T, M, 6144, D}; pg8::StaticOrder S; S.init(M, 6144, G, bx);
            pg8::EpiQKV E{Sk(1), (size_t)SLOT / 2, cs, attn_body::C2};
            pg8::gemm_phase<pg8::EpiQKV, pg8::StaticOrder, PG8_ALIGN, PG8_SP2>(ldsl, g, S, E);
#endif
    }
    if constexpr (SUB >= 2 && SUB <= 4) {
#if (PHM >> 2) & 1
            PHASE_LOCALS
            const int pat = SUB - 2, dil = (pat == 0) ? 1 : (pat == 1) ? 4 : 16;
            attn_body::mixa_phase(pat, dil, vcu, G, (const attn_body::bf16*)Sk(1), (const attn_body::bf16*)Sk(2), (const attn_body::bf16*)Sk(3), (attn_body::bf16*)Sk(7), Mst, Lst, (char*)lds);
#endif
    }
    if constexpr (SUB == 5) {
#if (PHM >> 5) & 1
            PHASE_LOCALS
            for (int L = vcu; L < 2048; L += G) {
                int bh, qb;
                if (G == 256) { const int i = L / 256, s = vcu & 7, j = i & 3; bh = (vcu >> 3) + 32 * (i >> 2); qb = (j == 0) ? s : (j == 1) ? 15 - s : (j == 2) ? 16 + s : 31 - s; }
                else { bh = L >> 5; qb = L & 31; }
                const int b = bh >> 5, vh = bh & 31, h = vh >> 2, mm = (vh >> 1) & 1, e = vh & 1;
                attn_body::attn_unit<8>(b, 0, qb, (const attn_body::bf16*)Sk(4) + (2 * h + mm) * 64, (const attn_body::bf16*)Sk(5) + (2 * h + mm) * 64, (const attn_body::bf16*)Sk(6) + (2 * h + e) * 64,
                                        (attn_body::bf16*)Sk(mm ? 2 : 1) + (2 * h + e) * 64, (char*)lds);
            }
#endif
    }
    if constexpr (SUB == 6) {
#if (PHM >> 6) & 1
            PHASE_LOCALS
            const float li = (layer == 0) ? 0.2f : 0.35550907f;
            const float* lq1 = ap->in[3] + layer * 64; const float* lk1 = ap->in[4] + layer * 64; const float* lq2 = ap->in[5] + layer * 64; const float* lk2 = ap->in[6] + layer * 64;
            const float lam = __expf(wave_sum(lq1[lane] * lk1[lane])) - __expf(wave_sum(lq2[lane] * lk2[lane])) + li;
            const float* sw = ap->in[7] + layer * 128;
            for (int m = gw; m < M; m += NGW) diff_row(Sk(1) + (size_t)m * D, Sk(2) + (size_t)m * D, sw, lam, 1.f - li, lane);
#endif
    }
    if constexpr (SUB == 7) {
#if (PHM >> 7) & 1
            PHASE_LOCALS
            pg8::Gemm g{S0, WIN_T + (size_t)6144 * D, M, 4096, D}; pg8::StaticOrder S; S.init(M, 4096, G, bx);
            pg8::EpiZG E{Sk(3), (size_t)SLOT / 2, Sk(7), Sk(1)};
            pg8::gemm_phase<pg8::EpiZG, pg8::StaticOrder, PG8_ALIGN, PG8_SP2>(ldsl, g, S, E);
#endif
    }
    if constexpr (SUB == 8) {
#if (PHM >> 8) & 1
            PHASE_LOCALS
            static_assert(W_B == W_A + (size_t)D * D * 2 && SLOT == (size_t)M * D * 2, "yB / Wb_t must sit right behind yA / Wa_t");
            pg8::Gemm g{Sk(3), WA_T, 2 * M, 2 * D, D}; pg8::PairOrder S; S.base.init(M, D, G, bx);
            pg8::EpiPair E{pg8::EpiGateF32{(float*)Sk(0), Sk(5)}, pg8::EpiMerge{(const float*)Sk(0), Sk(6), Sk(2)}};
            pg8::gemm_phase<pg8::EpiPair, pg8::PairOrder, PG8_ALIGN, PG8_SP2>(ldsl, g, S, E);
#endif
    }
    if constexpr (SUB == 9) {
#if (PHM >> 9) & 1
            PHASE_LOCALS
            pg8::Gemm g{Sk(4), WB_T, M, D, D}; pg8::StaticOrder S; S.init(M, D, G, bx);
            pg8::EpiMerge E{(const float*)Sk(0), Sk(6), Sk(2)};
            pg8::gemm_phase<pg8::EpiMerge, pg8::StaticOrder, PG8_ALIGN, PG8_SP2>(ldsl, g, S, E);
#endif
    }
    if constexpr (SUB == 10) {
#if (PHM >> 10) & 1
            PHASE_LOCALS
            pg8::Gemm g{Sk(2), WO_T, M, D, D}; pg8::StaticOrder S; S.init(M, D, G, bx);
            pg8::EpiResid E{resid, out};
            pg8::gemm_phase<pg8::EpiResid, pg8::StaticOrder, PG8_ALIGN, PG8_SP2>(ldsl, g, S, E);
#endif
    }
    if constexpr (SUB == 100) {
#if (PHM >> 11) & 1
            PHASE_LOCALS
            for (int m = gw; m < M; m += NGW) rms_row_f32(out + (size_t)m * D, ap->in[11], lane);
#endif
    }
}
__global__ void __launch_bounds__(NWAVES * 64, 2) hybrid_fwd(Args args_unused) {
    int ph_lo, ph_hi, coop; { ArgsP ap0 = get_args(); ph_lo = ap0->ph_lo; ph_hi = ap0->ph_hi; coop = ap0->coop; }
    {   extern __shared__ __attribute__((aligned(16))) unsigned char lds[];
        LAS unsigned* lctl = (LAS unsigned*)((LAS unsigned char*)lds + MISC_OFF);
        for (int u = threadIdx.x; u < (LDS_BYTES - MISC_OFF) / 4; u += NWAVES * 64) lctl[u] = 0u;
        __syncthreads();
        if (coop) { ArgsP ap0 = get_args(); (void)xcd_barrier_post((unsigned*)ap0->ws, (volatile LAS unsigned*)((LAS unsigned char*)lds + MISC_OFF) + 8); }
    }
#define GRID_SYNC(first) do { if (coop == 2) cg::this_grid().sync();   else { extern __shared__ __attribute__((aligned(16))) unsigned char lds[]; ArgsP ap1 = get_args(); \
        XcdBarrier xb_; xb_.bar = (unsigned*)ap1->ws; xb_.x = xb_xcc_id(); xb_.st = (volatile LAS unsigned*)((LAS unsigned char*)lds + MISC_OFF) + 8; xcd_barrier(xb_); } } while (0)
#define RUN(L, S) do { const int ph_ = (S == 100) ? N_PHASES - 1 : (L) * PH_PER_LAYER + (S); if (ph_lo <= ph_ && ph_ < ph_hi) { run_phase<S>(L); if (ph_ + 1 < ph_hi && coop) GRID_SYNC(ph_ == 0); } } while (0)
#ifndef PROBE_REP
#define PROBE_REP 0
#endif
#define RUNX(L, S) do { run_phase<S>(L); if (coop) GRID_SYNC(0); } while (0)
#define RUN_LAYER(L) RUN(L, 0); if (PROBE_REP == 3) RUNX(L, 1); RUN(L, 1); if (PROBE_REP == 1) { RUNX(L, 2); RUNX(L, 3); RUNX(L, 4); } RUN(L, 2); RUN(L, 3); RUN(L, 4); if (PROBE_REP == 2) RUNX(L, 5); RUN(L, 5); RUN(L, 6); RUN(L, 7); RUN(L, 8);   RUN(L, 10)
#if LAYER_LOOP
#pragma unroll 1
    for (int layer = 0; layer < DEPTH; ++layer) { RUN_LAYER(layer); }
#else
    RUN_LAYER(0); RUN_LAYER(1);
#endif
    RUN(DEPTH, 100);
}

extern "C" void kernel_launch(void* const* d_in, const int* in_sizes, int n_in, void* d_out, int out_size, void* d_ws, size_t ws_size, hipStream_t stream) {
    static int grid = 0;
    if (grid == 0) {
        if (n_in != 12 || in_sizes[0] != M * D || out_size != M * D || ws_size < WS_END) { fprintf(stderr, "kernel_launch: unexpected shapes / workspace (n_in %d, in0 %d, out %d, ws %zu, need %zu)\n", n_in, n_in > 0 ? in_sizes[0] : -1, out_size, ws_size, (size_t)WS_END); grid = -1; return; }
        int dev = 0, cus = 0, per_cu = 0;
        if (hipGetDevice(&dev) != hipSuccess || hipDeviceGetAttribute(&cus, hipDeviceAttributeMultiprocessorCount, dev) != hipSuccess) { grid = -1; return; }
        if (hipFuncSetAttribute((const void*)hybrid_fwd, hipFuncAttributeMaxDynamicSharedMemorySize, LDS_BYTES) != hipSuccess) { fprintf(stderr, "kernel_launch: hipFuncSetAttribute failed\n"); grid = -1; return; }
        if (hipOccupancyMaxActiveBlocksPerMultiprocessor(&per_cu, (const void*)hybrid_fwd, NWAVES * 64, LDS_BYTES) != hipSuccess || per_cu < 1) { fprintf(stderr, "kernel_launch: occupancy query says %d\n", per_cu); per_cu = 1; }
        (void)hipGetLastError();
        grid = cus;
    }
    if (grid < 0) return;
    if (hipMemsetAsync(d_ws, 0, CTL_ZERO_BYTES, stream) != hipSuccess) { fprintf(stderr, "kernel_launch: hipMemsetAsync failed\n"); return; }
    Args a{};
    for (int i = 0; i < 12; ++i) a.in[i] = (const float*)d_in[i];
    a.out = (float*)d_out; a.ws = (unsigned char*)d_ws;
#if MK_COOP
    a.ph_lo = 0; a.ph_hi = N_PHASES; a.coop = 1;
    void* kargs[] = {&a};
    hipError_t e = hipLaunchCooperativeKernel((const void*)hybrid_fwd, dim3(grid), dim3(NWAVES * 64), kargs, LDS_BYTES, stream);
    if (e != hipSuccess) fprintf(stderr, "kernel_launch: cooperative launch failed: %s (grid %d)\n", hipGetErrorString(e), grid);
#else
    for (int ph = 0; ph < N_PHASES; ++ph) {
        a.ph_lo = ph; a.ph_hi = ph + 1; a.coop = 0;
        hipLaunchKernelGGL(hybrid_fwd, dim3(grid), dim3(NWAVES * 64), LDS_BYTES, stream, a);
    }
#endif
}
```
